# Optimizing an MI355X kernel written in HIP

```python
import math
import jax, jax.numpy as jnp
from jax import lax
import numpy as np

D_MODEL = 1024
BATCH = 8
SEQ = 4096
DEPTH = 2

HEAD_DIM = 64
D_MIX = D_MODEL
ATTN_WIDTH = D_MIX // 2
ATTN_Q_HEADS = ATTN_WIDTH // HEAD_DIM
ATTN_KV_HEADS = ATTN_Q_HEADS // 4
ATTN_GROUP = ATTN_Q_HEADS // ATTN_KV_HEADS
KV_WIDTH = ATTN_KV_HEADS * HEAD_DIM
WINDOW = 128
BLOCK = 128
ROPE_THETA = 500000.0
ROT_DIM = HEAD_DIM // 4
GM_WIDTH = D_MIX // 4
GM_HEADS = GM_WIDTH // HEAD_DIM
CHUNK = 128
CONV_CH = D_MIX - ATTN_WIDTH - GM_WIDTH
CONV_WIDTH = 31
CONV_PAD = CONV_WIDTH // 2
D_FF = ((8 * D_MODEL // 3 + 255) // 256) * 256
PLE_DIM = 256
EPS = 1e-6
NEG_INF = -1e30

Q_OFF = 0
K_OFF = Q_OFF + ATTN_WIDTH
V_OFF = K_OFF + KV_WIDTH
GM_OFF = V_OFF + KV_WIDTH
CONV_OFF = GM_OFF + 2 * GM_WIDTH
IN_COLS = CONV_OFF + 2 * CONV_CH

kernel_name = "hymba_style_hybrid_encoder_block"


def rms_norm(x, g):
    xf = x.astype(jnp.float32)
    y = xf * lax.rsqrt(jnp.mean(xf * xf, axis=-1, keepdims=True) + EPS)
    return (y * g.astype(jnp.float32)).astype(x.dtype)


def layer_norm(x, g, b):
    xf = x.astype(jnp.float32)
    mu = jnp.mean(xf, axis=-1, keepdims=True)
    xc = xf - mu
    y = xc * lax.rsqrt(jnp.mean(xc * xc, axis=-1, keepdims=True) + EPS)
    return (y * g.astype(jnp.float32) + b.astype(jnp.float32)).astype(x.dtype)


def rope_tables(positions):
    inv_freq = ROPE_THETA ** (-jnp.arange(0, ROT_DIM, 2, dtype=jnp.float32) / ROT_DIM)
    ang = positions.astype(jnp.float32)[..., None] * inv_freq
    return jnp.cos(ang)[:, :, None, :], jnp.sin(ang)[:, :, None, :]


def apply_partial_rope(x, cos, sin):
    xr = x[..., :ROT_DIM].astype(jnp.float32)
    half = ROT_DIM // 2
    x1, x2 = xr[..., :half], xr[..., half:]
    rot = jnp.concatenate([x1 * cos - x2 * sin, x2 * cos + x1 * sin], axis=-1)
    return jnp.concatenate([rot.astype(x.dtype), x[..., ROT_DIM:]], axis=-1)


def band_mask(n_blocks, seq):
    qi = jnp.arange(BLOCK)[:, None]
    kj = jnp.arange(3 * BLOCK)[None, :]
    rel = kj - BLOCK - qi
    in_band = jnp.abs(rel) <= WINDOW
    key_abs = jnp.arange(n_blocks)[:, None, None] * BLOCK - BLOCK + kj[None]
    in_range = (key_abs >= 0) & (key_abs < seq)
    return in_band[None] & in_range


def windowed_gqa_with_sink(q, k, v, sink):
    B, S = q.shape[0], q.shape[1]
    nb = S // BLOCK
    qb = q.reshape(B, nb, BLOCK, ATTN_KV_HEADS, ATTN_GROUP, HEAD_DIM)
    pad = ((0, 0), (BLOCK, BLOCK), (0, 0), (0, 0))
    kp = jnp.pad(k, pad).reshape(B, nb + 2, BLOCK, ATTN_KV_HEADS, HEAD_DIM)
    vp = jnp.pad(v, pad).reshape(B, nb + 2, BLOCK, ATTN_KV_HEADS, HEAD_DIM)
    kw = jnp.concatenate([kp[:, :-2], kp[:, 1:-1], kp[:, 2:]], axis=2)
    vw = jnp.concatenate([vp[:, :-2], vp[:, 1:-1], vp[:, 2:]], axis=2)
    s = jnp.einsum('bnqhgd,bnkhd->bnhgqk', qb, kw,
                   preferred_element_type=jnp.float32) * (1.0 / math.sqrt(HEAD_DIM))
    mask = band_mask(nb, S)[None, :, None, None]
    s = jnp.where(mask, s, NEG_INF)
    sink_l = sink.astype(jnp.float32).reshape(ATTN_KV_HEADS, ATTN_GROUP)[None, None, :, :, None, None]
    m = jnp.maximum(jnp.max(s, axis=-1, keepdims=True), sink_l)
    e = jnp.exp(s - m)
    denom = jnp.sum(e, axis=-1, keepdims=True) + jnp.exp(sink_l - m)
    pr = (e / denom).astype(v.dtype)
    o = jnp.einsum('bnhgqk,bnkhd->bnqhgd', pr, vw)
    return o.reshape(B, S, ATTN_WIDTH)


def spatial_gating(uv, ln_g, ln_b, ws, bs):
    B, S = uv.shape[0], uv.shape[1]
    u, v = uv[..., :GM_WIDTH], uv[..., GM_WIDTH:]
    v = layer_norm(v, ln_g, ln_b)
    vb = v.reshape(B, S // CHUNK, CHUNK, GM_HEADS, HEAD_DIM)
    sg = jnp.einsum('hpq,bnqhd->bnphd', ws, vb) + bs.T[None, None, :, :, None]
    return u * sg.reshape(B, S, GM_WIDTH)


def conformer_conv(ag, conv_w, conv_b, ln_g, ln_b):
    a, g = ag[..., :CONV_CH], ag[..., CONV_CH:]
    glu = a * jax.nn.sigmoid(g)
    y = lax.conv_general_dilated(glu, conv_w[:, None, :], window_strides=(1,),
                                 padding=[(CONV_PAD, CONV_PAD)],
                                 dimension_numbers=('NWC', 'WIO', 'NWC'),
                                 feature_group_count=CONV_CH) + conv_b
    y = layer_norm(y, ln_g, ln_b)
    return jax.nn.silu(y)


def setup_inputs(seed: int = 0) -> dict:
    key = jax.random.key(seed)
    ks = jax.random.split(key, 24)
    f32 = jnp.float32

    def nrm(k, shape, scale):
        return jax.random.normal(k, shape, f32) * scale

    def gain(k, shape):
        return 1.0 + 0.02 * jax.random.normal(k, shape, f32)

    x = jax.random.normal(ks[0], (BATCH, SEQ, D_MODEL), f32)
    p = jax.random.normal(ks[1], (DEPTH, BATCH, SEQ, PLE_DIM), f32)
    positions = jnp.broadcast_to(jnp.arange(SEQ, dtype=jnp.int32), (BATCH, SEQ))
    return {
        "x": x,
        "p": p,
        "positions": positions,
        "norm_mix_g": gain(ks[2], (DEPTH, D_MODEL)),
        "w_in": nrm(ks[3], (DEPTH, D_MODEL, IN_COLS), D_MODEL ** -0.5),
        "q_norm_g": gain(ks[4], (DEPTH, HEAD_DIM)),
        "k_norm_g": gain(ks[5], (DEPTH, HEAD_DIM)),
        "sink": nrm(ks[6], (DEPTH, ATTN_Q_HEADS), 0.5),
        "gm_ln_g": gain(ks[7], (DEPTH, GM_WIDTH)),
        "gm_ln_b": nrm(ks[8], (DEPTH, GM_WIDTH), 0.02),
        "gm_ws": nrm(ks[9], (DEPTH, GM_HEADS, CHUNK, CHUNK), CHUNK ** -0.5),
        "gm_bs": gain(ks[10], (DEPTH, GM_HEADS, CHUNK)),
        "conv_w": nrm(ks[11], (DEPTH, CONV_WIDTH, CONV_CH), CONV_WIDTH ** -0.5),
        "conv_b": nrm(ks[12], (DEPTH, CONV_CH), 0.02),
        "conv_ln_g": gain(ks[13], (DEPTH, CONV_CH)),
        "conv_ln_b": nrm(ks[14], (DEPTH, CONV_CH), 0.02),
        "out_norm_g": gain(ks[15], (DEPTH, D_MIX)),
        "w_out": nrm(ks[16], (DEPTH, D_MIX, D_MODEL), D_MIX ** -0.5),
        "norm_ffn_g": gain(ks[17], (DEPTH, D_MODEL)),
        "w_gate_up": nrm(ks[18], (DEPTH, D_MODEL, 2 * D_FF), D_MODEL ** -0.5),
        "w_down": nrm(ks[19], (DEPTH, D_FF, D_MODEL), D_FF ** -0.5),
        "ple_norm_g": gain(ks[20], (DEPTH, D_MODEL)),
        "w_ple_gate": nrm(ks[21], (DEPTH, D_MODEL, D_MODEL), D_MODEL ** -0.5),
        "w_ple_proj": nrm(ks[22], (DEPTH, PLE_DIM, D_MODEL), PLE_DIM ** -0.5),
    }


def reference(x, p, positions, norm_mix_g, w_in, q_norm_g, k_norm_g, sink,
              gm_ln_g, gm_ln_b, gm_ws, gm_bs, conv_w, conv_b, conv_ln_g, conv_ln_b,
              out_norm_g, w_out, norm_ffn_g, w_gate_up, w_down,
              ple_norm_g, w_ple_gate, w_ple_proj):
    B, S = x.shape[0], x.shape[1]
    cos, sin = rope_tables(positions)
    for i in range(DEPTH):
        h = rms_norm(x, norm_mix_g[i])
        z = h @ w_in[i]

        q = z[..., Q_OFF:K_OFF].reshape(B, S, ATTN_Q_HEADS, HEAD_DIM)
        k = z[..., K_OFF:V_OFF].reshape(B, S, ATTN_KV_HEADS, HEAD_DIM)
        v = z[..., V_OFF:GM_OFF].reshape(B, S, ATTN_KV_HEADS, HEAD_DIM)
        q = apply_partial_rope(rms_norm(q, q_norm_g[i]), cos, sin)
        k = apply_partial_rope(rms_norm(k, k_norm_g[i]), cos, sin)
        o_attn = windowed_gqa_with_sink(q, k, v, sink[i])

        uv = jax.nn.gelu(z[..., GM_OFF:CONV_OFF], approximate=False)
        o_gm = spatial_gating(uv, gm_ln_g[i], gm_ln_b[i], gm_ws[i], gm_bs[i])

        o_conv = conformer_conv(z[..., CONV_OFF:IN_COLS], conv_w[i], conv_b[i],
                                conv_ln_g[i], conv_ln_b[i])

        g_out = out_norm_g[i]
        merged = jnp.concatenate([
            rms_norm(o_attn, g_out[:ATTN_WIDTH]),
            rms_norm(o_gm, g_out[ATTN_WIDTH:ATTN_WIDTH + GM_WIDTH]),
            rms_norm(o_conv, g_out[ATTN_WIDTH + GM_WIDTH:]),
        ], axis=-1)
        x = x + merged @ w_out[i]

        hf = rms_norm(x, norm_ffn_g[i]) @ w_gate_up[i]
        x = x + (jax.nn.silu(hf[..., :D_FF]) * hf[..., D_FF:]) @ w_down[i]

        gate = jax.nn.sigmoid(rms_norm(x, ple_norm_g[i]) @ w_ple_gate[i])
        x = x + (p[i] @ w_ple_proj[i]) * gate
    return x
```

```cpp
#include <hip/hip_runtime.h>
#include <cstdio>
#include <cstdint>
#include <type_traits>

#ifndef REP_GU
#define REP_GU 1
#endif
#ifndef REP_IP
#define REP_IP 1
#endif
#ifndef REP_MIX
#define REP_MIX 1
#endif
#ifndef REPEAT_STEP
#define REPEAT_STEP -1
#endif
#ifndef ATT_STAGGER
#define ATT_STAGGER 40
#endif
#ifndef MK_N_LAUNCHES
#define MK_N_LAUNCHES 1
#endif

constexpr int D_MODEL = 1024, BATCH = 8, SEQ = 4096, DEPTH = 2, M = BATCH * SEQ;
constexpr int HEAD_DIM = 64, ATTN_WIDTH = 512, NQH = 8, NKVH = 2, KV_WIDTH = 128, WINDOW = 128;
constexpr int GM_WIDTH = 256, GM_HEADS = 4, CHUNK = 128, CONV_CH = 256, CONV_W = 31, CONV_PAD = 15, D_FF = 2816, PLE_DIM = 256;
constexpr int Q_OFF = 0, K_OFF = 512, V_OFF = 640, GM_OFF = 768, CONV_OFF = 1280, IN_COLS = 1792;
constexpr float EPS = 1e-6f;
constexpr int DOWN_K8 = 2048;
constexpr int ACT_ROW_BYTES = DOWN_K8 + 2 * (D_FF - DOWN_K8);
static_assert(DOWN_K8 % 256 == 0 && ACT_ROW_BYTES % 256 == 0, "whole pairs of 128-byte K-tiles on both sides of the split");
constexpr int RB = 8;
constexpr float LOG2E = 1.4426950408889634f;
constexpr float C2 = 0.125f * 1.4426950408889634f;

enum { I_X = 0, I_P, I_POS, I_NORM_MIX_G, I_W_IN, I_QG, I_KG, I_SINK, I_GM_LN_G, I_GM_LN_B, I_GM_WS, I_GM_BS, I_CONV_W, I_CONV_B, I_CONV_LN_G, I_CONV_LN_B,
       I_OUT_NORM_G, I_W_OUT, I_NORM_FFN_G, I_W_GU, I_W_DOWN, I_PLE_NORM_G, I_W_PG, I_W_PP, N_IN };

constexpr size_t MiB = 1u << 20;
constexpr size_t WS_CTL = 0, CTL_ZERO_BYTES = 1 * MiB;
constexpr size_t WS_COS = 1 * MiB, WS_SIN = 2 * MiB;
constexpr size_t WS_PARTA = 3 * MiB, WS_PARTB = 5 * MiB;
constexpr size_t WS_VSTAT = 7 * MiB;
constexpr size_t WS_ARSTD = 7 * MiB;
constexpr size_t WS_WSBF = 7 * MiB + 512 * 1024;
constexpr size_t WS_W = 8 * MiB, W_LAYER = 24 * MiB + 512 * 1024;
constexpr size_t WO_IN = 0, WO_OUT = 3 * MiB + 512 * 1024, WO_GU = 5 * MiB + 512 * 1024, WO_DOWN = 16 * MiB + 512 * 1024, WO_PG = 22 * MiB, WO_PP = 24 * MiB;
static_assert(WS_W + 2 * W_LAYER <= 64 * MiB, "weight copies end below xbf");
constexpr size_t WS_XBF = 64 * MiB;
constexpr size_t WS_PJ = 128 * MiB;
constexpr size_t WS_PBF = 192 * MiB;
constexpr size_t WS_R1 = 224 * MiB;
constexpr size_t WS_Q = WS_R1, WS_K = WS_R1 + 32 * MiB, WS_V = WS_R1 + 40 * MiB, WS_U = WS_R1 + 48 * MiB, WS_VV = WS_R1 + 64 * MiB, WS_GLU = WS_R1 + 80 * MiB;
constexpr size_t WS_MERGED = WS_R1 + 96 * MiB;
constexpr size_t WS_XBF2 = 400 * MiB;
constexpr size_t WS_ACT = WS_R1;
constexpr size_t WS_X8 = 464 * MiB;
constexpr size_t WS_END = 496 * MiB;

typedef unsigned short bf16;
typedef float f32x4 __attribute__((ext_vector_type(4)));
typedef unsigned u32x4 __attribute__((ext_vector_type(4)));
typedef unsigned u32x2 __attribute__((ext_vector_type(2)));
#define LAS __attribute__((address_space(3)))
#define GAS __attribute__((address_space(1)))
typedef GAS unsigned gu32;
#define RLX_AGENT __ATOMIC_RELAXED, __HIP_MEMORY_SCOPE_AGENT

__device__ __forceinline__ unsigned f2bf(float f) { unsigned u = __builtin_bit_cast(unsigned, f); return (u + 0x7fffu + ((u >> 16) & 1u)) >> 16; }
__device__ __forceinline__ unsigned pk2(float lo, float hi) { return f2bf(lo) | (f2bf(hi) << 16); }
__device__ __forceinline__ float bflo(unsigned u) { return __builtin_bit_cast(float, u << 16); }
__device__ __forceinline__ float bfhi(unsigned u) { return __builtin_bit_cast(float, u & 0xffff0000u); }
__device__ __forceinline__ float bf2f(bf16 b) { return __builtin_bit_cast(float, (unsigned)b << 16); }
#define dpp_(x, ctrl, row_mask, bc) __builtin_bit_cast(float, __builtin_amdgcn_update_dpp(0, __builtin_bit_cast(int, (x)), (ctrl), (row_mask), 0xf, (bc)))
__device__ __forceinline__ float wave_sum(float v) {
    v += dpp_(v, 0xB1, 0xf, true); v += dpp_(v, 0x4E, 0xf, true); v += dpp_(v, 0x141, 0xf, true); v += dpp_(v, 0x140, 0xf, true);
    v += dpp_(v, 0x142, 0xa, false); v += dpp_(v, 0x143, 0xc, false);
    return __builtin_bit_cast(float, __builtin_amdgcn_readlane(__builtin_bit_cast(int, v), 63));
}
__device__ __forceinline__ float rowsum16(float v) { v += dpp_(v, 0xB1, 0xf, true); v += dpp_(v, 0x4E, 0xf, true); v += dpp_(v, 0x141, 0xf, true); v += dpp_(v, 0x140, 0xf, true); return v; }
__device__ __forceinline__ float xsum_16_32(float v) {
    const unsigned a = __builtin_bit_cast(unsigned, v); const auto r = __builtin_amdgcn_permlane16_swap(a, a, false, false);
    v = __builtin_bit_cast(float, (unsigned)r[0]) + __builtin_bit_cast(float, (unsigned)r[1]);
    const unsigned b = __builtin_bit_cast(unsigned, v); const auto q = __builtin_amdgcn_permlane32_swap(b, b, false, false);
    return __builtin_bit_cast(float, (unsigned)q[0]) + __builtin_bit_cast(float, (unsigned)q[1]);
}
__device__ __forceinline__ float xmax_16_32(float v) {
    const unsigned a = __builtin_bit_cast(unsigned, v); const auto r = __builtin_amdgcn_permlane16_swap(a, a, false, false);
    v = fmaxf(__builtin_bit_cast(float, (unsigned)r[0]), __builtin_bit_cast(float, (unsigned)r[1]));
    const unsigned b = __builtin_bit_cast(unsigned, v); const auto q = __builtin_amdgcn_permlane32_swap(b, b, false, false);
    return fmaxf(__builtin_bit_cast(float, (unsigned)q[0]), __builtin_bit_cast(float, (unsigned)q[1]));
}
__device__ __forceinline__ int lane_id() { int l; asm volatile("v_mbcnt_lo_u32_b32 %0, -1, 0\n\tv_mbcnt_hi_u32_b32 %0, -1, %0" : "=v"(l)); return l; }
__host__ __device__ __forceinline__ size_t tiled_off(int row, int bytecol, int rowbytes) { return ((size_t)((row >> 4) * (rowbytes >> 6) + (bytecol >> 6)) << 10) + (size_t)(((row & 15) << 6) + (bytecol & 63)); }
__device__ __forceinline__ float sigmoidf_(float x) { return 1.0f / (1.0f + __expf(-x)); }

#define XB_TMO      128
#define XB_XCNT(j)  (256  + 64 * (j))
#define XB_XSUB(j)  (1280 + 64 * (j))
#define XB_XGEN(j)  (2304 + 64 * (j))
#define XB_TOP      3328
#define XB_TOPGEN   3392
#define XCD_BAR_WORDS 3456
#define XB_SPIN_CAP (1u << 22)
constexpr int CW_BAR = 4096;

__device__ __forceinline__ unsigned xb_ld(unsigned* p)              { return __hip_atomic_load(p, __ATOMIC_RELAXED, __HIP_MEMORY_SCOPE_AGENT); }
__device__ __forceinline__ unsigned xb_add(unsigned* p, unsigned v) { return __hip_atomic_fetch_add(p, v, __ATOMIC_RELAXED, __HIP_MEMORY_SCOPE_AGENT); }
__device__ __forceinline__ unsigned xb_xcc_id() { return (unsigned)__builtin_amdgcn_s_getreg((3 << 11) | 20) & 0xFu; }
#define XB_SPIN(cond, bar) do { unsigned _sp = 0; while (cond) { __builtin_amdgcn_s_sleep(1); \
    if ((++_sp & 255u) == 0u) { if (xb_ld(&(bar)[XB_TMO])) break; if (_sp > XB_SPIN_CAP) { atomicAdd(&(bar)[XB_TMO], 1u); break; } } } } while (0)

struct XcdBarrier { unsigned* bar; unsigned x; volatile LAS unsigned* st; };
__device__ __forceinline__ XcdBarrier xcd_barrier_post(unsigned* bar, volatile LAS unsigned* st, bool leader) {
    XcdBarrier b; b.bar = bar; b.x = xb_xcc_id(); b.st = st;
    if (leader) (void)xb_add(&bar[XB_XCNT(b.x)], 1u);
    return b;
}
__device__ __forceinline__ void xcd_barrier_complete(unsigned* bar, unsigned x, unsigned& nloc, unsigned& nx) {
    const unsigned G = gridDim.x * gridDim.y * gridDim.z;
    unsigned sum, cnt, mine, sp = 0u;
    for (;;) {
        sum = 0u; cnt = 0u; mine = 0u;
#pragma unroll
        for (unsigned j = 0; j < 16; ++j) { const unsigned c = xb_ld(&bar[XB_XCNT(j)]); sum += c; cnt += (c > 0u) ? 1u : 0u; mine = (j == x) ? c : mine; }
        if (sum == G) break;
        __builtin_amdgcn_s_sleep(1);
        if ((++sp & 255u) == 0u) { if (xb_ld(&bar[XB_TMO])) break; if (sp > XB_SPIN_CAP) { atomicAdd(&bar[XB_TMO], 1u); break; } }
    }
    nloc = mine > 0u ? mine : 1u; nx = cnt > 0u ? cnt : 1u;
}
__device__ __forceinline__ void xcd_barrier(const XcdBarrier& b, bool leader) {
    asm volatile("s_waitcnt vmcnt(0)" ::: "memory");
    __syncthreads();
    if (leader) {
        unsigned* bar = b.bar;
        __builtin_amdgcn_s_waitcnt(0);
        unsigned nloc = b.st[0], nx = b.st[1];
        if (nloc == 0u) { xcd_barrier_complete(bar, b.x, nloc, nx); b.st[0] = nloc; b.st[1] = nx; }
        const unsigned old = xb_add(&bar[XB_XSUB(b.x)], 1u);
        const unsigned gen = old / nloc;
        if (old + 1u == (gen + 1u) * nloc) {
            __builtin_amdgcn_fence(__ATOMIC_RELEASE, "agent");
            asm volatile("s_waitcnt vmcnt(0)" ::: "memory");
            (void)xb_add(&bar[XB_TOP], 1u);
        }
        XB_SPIN(xb_ld(&bar[XB_TOP]) < (gen + 1u) * nx, bar);
        __builtin_amdgcn_fence(__ATOMIC_ACQUIRE, "agent");
        asm volatile("s_waitcnt vmcnt(0)" ::: "memory");
    }
    __syncthreads();
}

namespace pg8 {
#define PG8_LAS __attribute__((address_space(3)))
typedef unsigned short bf16_t;
typedef short bf16x8 __attribute__((ext_vector_type(8)));
typedef float f32x4 __attribute__((ext_vector_type(4)));
typedef unsigned u32x4 __attribute__((ext_vector_type(4)));
constexpr int BM = 256, BK = 64, HALF = 128, HTB = HALF * BK * 2  , STAGE_BYTES = 8 * HTB, NXCD = 8, WGM = 8;

__host__ __device__ __forceinline__ int lds_byte(int r, int c) { const int st = (r >> 4) * 2 + (c >> 5), rr = r & 15, cc = c & 31, ob = rr * 64 + cc * 2; return st * 1024 + (ob ^ (((ob >> 9) & 1) << 5)); }
__host__ __device__ __forceinline__ void stage_rc(int b, int& R, int& C) { const int st = b / 1024, sb = b % 1024, swz = sb ^ (((sb >> 9) & 1) << 5); R = (st >> 1) * 16 + swz / 64; C = (st & 1) * 32 + (swz % 64) / 2; }
__host__ __device__ __forceinline__ int perm32(int rho) { const int n = rho >> 4, i = rho & 15; return 8 * (i >> 2) + 4 * n + (i & 3); }

struct Unit { int pm, pn; };
struct Gemm { const bf16_t* A; const bf16_t* Bt; int M, N, K; int nt8 = 0; };

struct StaticOrder {
    int nM, nN, nwg, G, c;
    __host__ __device__ void init(int M, int N, int G_, int c_) { nM = M / BM; nN = N / BM; nwg = nM * nN; G = G_; c = c_; }
    __host__ __device__ bool next(int i, Unit& u) const {
        const long L = (long)i * G + c; if (L >= nwg) return false;
        int wgid = (int)L; { const int q = nwg / NXCD, r = nwg % NXCD, xcd = wgid % NXCD, off = wgid / NXCD; wgid = (xcd < r ? xcd * (q + 1) : r * (q + 1) + (xcd - r) * q) + off; }
        const int nig = WGM * nN, gid = wgid / nig, fm = gid * WGM, gsz = (nM - fm) < WGM ? (nM - fm) : WGM;
        u.pm = fm + ((wgid % nig) % gsz); u.pn = (wgid % nig) / gsz; return true;
    }
    __device__ __forceinline__ void a_ready(const Unit&) const {}
    __device__ __forceinline__ void done(const Unit&) const {}
};

__device__ __forceinline__ unsigned cvt_pk_bf16(float lo, float hi) { unsigned r; asm volatile("v_cvt_pk_bf16_f32 %0, %1, %2" : "=v"(r) : "v"(lo), "v"(hi)); return r; }
typedef int i32x4 __attribute__((ext_vector_type(4)));
typedef int i32x8 __attribute__((ext_vector_type(8)));
typedef unsigned u32x2_ __attribute__((ext_vector_type(2)));
constexpr float W8_SCALE = 128.0f;
__device__ __forceinline__ u32x2_ pack8_fp8(const f32x4 a, const f32x4 b) {
    int lo = 0, hi = 0; lo = __builtin_amdgcn_cvt_pk_fp8_f32(a[0], a[1], lo, false); lo = __builtin_amdgcn_cvt_pk_fp8_f32(a[2], a[3], lo, true);
    hi = __builtin_amdgcn_cvt_pk_fp8_f32(b[0], b[1], hi, false); hi = __builtin_amdgcn_cvt_pk_fp8_f32(b[2], b[3], hi, true); return (u32x2_){(unsigned)lo, (unsigned)hi}; }
__device__ __forceinline__ void mfma_f8_acc(f32x4& c, const i32x8 a, const i32x8 b) { asm volatile("v_mfma_f32_16x16x128_f8f6f4 %0, %1, %2, %0" : "+v"(c) : "v"(a), "v"(b)); }
__device__ __forceinline__ i32x8 cat8(const bf16x8 a, const bf16x8 b) { return __builtin_shufflevector(__builtin_bit_cast(i32x4, a), __builtin_bit_cast(i32x4, b), 0, 1, 2, 3, 4, 5, 6, 7); }
__device__ __forceinline__ u32x4 pack8(const f32x4 a, const f32x4 b) { u32x4 w; w.x = cvt_pk_bf16(a[0], a[1]); w.y = cvt_pk_bf16(a[2], a[3]); w.z = cvt_pk_bf16(b[0], b[1]); w.w = cvt_pk_bf16(b[2], b[3]); return w; }
typedef float f32x2 __attribute__((ext_vector_type(2)));
__device__ __forceinline__ f32x2 gelu_pk(f32x2 v) {
    const f32x2 av = __builtin_elementwise_abs(v), d = av * 0.2316418882f + 1.0f;
    f32x2 t; t.x = __builtin_amdgcn_rcpf(d.x); t.y = __builtin_amdgcn_rcpf(d.y);
    f32x2 q = t * 0.5307027145f + (-0.7265760135f); q = q * t + 0.7107068705f; q = q * t + (-0.142248368f); q = q * t + 0.127414796f; q = q * t;
    const f32x2 s = (v * v) * (-0.72134752044f);
    f32x2 e; e.x = __builtin_amdgcn_exp2f(s.x); e.y = __builtin_amdgcn_exp2f(s.y);
    const f32x2 m = v * (q * e), r = v - m;
    f32x2 o; o.x = v.x < 0.f ? m.x : r.x; o.y = v.y < 0.f ? m.y : r.y; return o;
}
__device__ __forceinline__ f32x4 gelu4(const f32x4 v) { const f32x2 a = gelu_pk((f32x2){v[0], v[1]}), b = gelu_pk((f32x2){v[2], v[3]}); return (f32x4){a.x, a.y, b.x, b.y}; }
__device__ __forceinline__ float sigm(float x) { return __builtin_amdgcn_rcpf(1.0f + __builtin_amdgcn_exp2f(x * -1.4426950408889634f)); }
__device__ __forceinline__ f32x4 sigm4(const f32x4 v) { return (f32x4){sigm(v[0]), sigm(v[1]), sigm(v[2]), sigm(v[3])}; }
__device__ __forceinline__ float dot4(const f32x4 a) { return (a[0] * a[0] + a[1] * a[1]) + (a[2] * a[2] + a[3] * a[3]); }
constexpr int RT_OFF = 131072, RT_SLOTS = 4;
struct RstdTab { int pm0, pm1, pm2, pm3; PG8_LAS unsigned char* lds; };
__device__ __forceinline__ void epi_rstd(const RstdTab& T, int pm, int rloc  , float (&rs)[2][4]) {
    const int slot = (pm == T.pm0) ? 0 : (pm == T.pm1) ? 1 : (pm == T.pm2) ? 2 : 3;
    const PG8_LAS float* tp = (const PG8_LAS float*)(T.lds + RT_OFF + slot * 1024) + rloc;
#pragma unroll
    for (int ai = 0; ai < 2; ++ai)
#pragma unroll
        for (int m = 0; m < 4; ++m) rs[ai][m] = tp[ai * HALF + m * 16];
}
struct TabJob { const float* src; int mode; };
template <class Sched>
__device__ __forceinline__ RstdTab table_slots(PG8_LAS unsigned char* lds, const Sched& S) {
    RstdTab T; T.pm0 = T.pm1 = T.pm2 = T.pm3 = -1; T.lds = lds;
    Unit u;
    for (int i = 0; S.next(i, u); ++i) {
        if (u.pm == T.pm0 || u.pm == T.pm1 || u.pm == T.pm2 || u.pm == T.pm3) continue;
        if (T.pm0 < 0) T.pm0 = u.pm; else if (T.pm1 < 0) T.pm1 = u.pm; else if (T.pm2 < 0) T.pm2 = u.pm; else T.pm3 = u.pm;
    }
    return T;
}
__device__ __forceinline__ void table_fill(const RstdTab& T, const TabJob j, int tid) {
    const int slot = tid >> 7, r2 = tid & 127;
    const int pm = (slot == 0) ? T.pm0 : (slot == 1) ? T.pm1 : (slot == 2) ? T.pm2 : T.pm3;
    if (pm >= 0) {
#pragma unroll
        for (int h = 0; h < 2; ++h) {
            const float* pp = j.src + (pm * BM + r2 + 128 * h); float sum = pp[0];
            if (j.mode == 1) {
#pragma unroll
                for (int q = 1; q < 16; ++q) sum += pp[(size_t)q * M]; }
            *((PG8_LAS float*)(T.lds + RT_OFF + slot * 1024) + r2 + 128 * h) = (j.mode == 3) ? sum : __builtin_amdgcn_rsqf(sum * (1.0f / 1024.0f) + 1e-6f);
        }
    }
    __syncthreads();
}
struct EpiInProj {
    static constexpr bool PERM = true, AFTER_DRAIN = false;
    RstdTab rt; unsigned char* wsb; size_t oQ, oK, oV, oU, oVV, oGL, oCT, oST; const float *qg, *kg; float qscale;
    __device__ __forceinline__ void operator()(const f32x4 (&acc)[2][2][4][2], const Unit& u, int wr, int wc, int fr, int fq) const {
        asm volatile("" : "+v"(fr), "+v"(fq));
        const int rowb = u.pm * BM + wr * 64 + fr, pn = u.pn;
        unsigned char* wl = wsb; asm volatile("" : "+s"(wl));
        bf16_t* const Q = (bf16_t*)(wl + oQ); bf16_t* const K = (bf16_t*)(wl + oK); bf16_t* const V = (bf16_t*)(wl + oV); bf16_t* const U = (bf16_t*)(wl + oU); bf16_t* const VV = (bf16_t*)(wl + oVV); bf16_t* const GL = (bf16_t*)(wl + oGL);
        const float* const ct = (const float*)(wl + oCT); const float* const st = (const float*)(wl + oST);
        float rs[2][4]; epi_rstd(rt, u.pm, wr * 64 + fr, rs);
        if (pn < 2 || (pn == 2 && wc < 2)) {
            const bool isq = pn < 2; const float* gn = isq ? qg : kg; const float qs = isq ? qscale : 1.0f;
            bf16_t* O = isq ? Q + 64 * (4 * pn + wc) : K + 64 * wc; const int ldo = isq ? 512 : 128;
            const int d00 = (fq < 2) ? 4 * fq : 8 * fq, d01 = (fq < 2) ? 8 + 4 * fq : 8 * fq + 4;
            const f32x4 g00 = *(const f32x4*)(gn + d00), g01 = *(const f32x4*)(gn + d01), g10 = *(const f32x4*)(gn + 32 + 8 * fq), g11 = *(const f32x4*)(gn + 36 + 8 * fq);
#pragma unroll
            for (int ai = 0; ai < 2; ++ai)
#pragma unroll
                for (int m = 0; m < 4; ++m) {
                    const int row = rowb + ai * HALF + m * 16; const float r = rs[ai][m];
                    f32x4 z00 = acc[ai][0][m][0] * r, z01 = acc[ai][0][m][1] * r, z10 = acc[ai][1][m][0] * r, z11 = acc[ai][1][m][1] * r;
                    const float ss = xsum_16_32((dot4(z00) + dot4(z01)) + (dot4(z10) + dot4(z11)));
                    const float r2 = __builtin_amdgcn_rsqf(ss * (1.0f / 64.0f) + 1e-6f);
                    z00 = z00 * r2 * g00; z01 = z01 * r2 * g01; z10 = z10 * (r2 * qs) * g10; z11 = z11 * (r2 * qs) * g11;
                    f32x4 c = *(const f32x4*)(ct + (size_t)row * 8 + 4 * (fq & 1)), s = *(const f32x4*)(st + (size_t)row * 8 + 4 * (fq & 1));
                    if (fq >= 2) { c = (f32x4){1.f, 1.f, 1.f, 1.f}; s = (f32x4){0.f, 0.f, 0.f, 0.f}; }
                    const f32x4 x1 = (z00 * c - z01 * s) * qs, x2 = (z01 * c + z00 * s) * qs;
                    bf16_t* op = O + (size_t)row * ldo + 8 * fq;
                    *(u32x4*)op = pack8(x1, x2); *(u32x4*)(op + 32) = pack8(z10, z11);
                    asm volatile("" ::: "memory");
                }
        } else if (pn == 2) {
            bf16_t* O = V + 64 * (wc - 2) + 8 * fq;
#pragma unroll
            for (int ai = 0; ai < 2; ++ai)
#pragma unroll
                for (int m = 0; m < 4; ++m) { const int row = rowb + ai * HALF + m * 16; const float r = rs[ai][m];
#pragma unroll
                    for (int bj = 0; bj < 2; ++bj) *(u32x4*)(O + (size_t)row * 128 + 32 * bj) = pack8(acc[ai][bj][m][0] * r, acc[ai][bj][m][1] * r); }
        } else if (pn < 5) {
            bf16_t* O = (pn == 3 ? U : VV) + wc * 32 + 8 * fq;
#pragma unroll
            for (int ai = 0; ai < 2; ++ai)
#pragma unroll
                for (int m = 0; m < 4; ++m) { const int row = rowb + ai * HALF + m * 16; const float r = rs[ai][m];
#pragma unroll
                    for (int bj = 0; bj < 2; ++bj) *(u32x4*)(O + (size_t)row * 256 + HALF * bj) = pack8(gelu4(acc[ai][bj][m][0] * r), gelu4(acc[ai][bj][m][1] * r)); }
        } else {
            bf16_t* O = GL + 128 * (pn - 5) + wc * 32 + 8 * fq;
#pragma unroll
            for (int ai = 0; ai < 2; ++ai)
#pragma unroll
                for (int m = 0; m < 4; ++m) { const int row = rowb + ai * HALF + m * 16; const float r = rs[ai][m];
                    const f32x4 a0 = acc[ai][0][m][0] * r, a1 = acc[ai][0][m][1] * r, g0 = acc[ai][1][m][0] * r, g1 = acc[ai][1][m][1] * r;
                    *(u32x4*)(O + (size_t)row * 256) = pack8(a0 * sigm4(g0), a1 * sigm4(g1)); }
        }
    }
};
struct EpiStore {
    static constexpr bool PERM = true, AFTER_DRAIN = false;
    bf16_t* O; int ldc;
    __device__ __forceinline__ void operator()(const f32x4 (&acc)[2][2][4][2], const Unit& u, int wr, int wc, int fr, int fq) const {
        asm volatile("" : "+v"(fr), "+v"(fq));
        const int rowb = u.pm * BM + wr * 64 + fr, colb = u.pn * BM + wc * 32 + 8 * fq;
#pragma unroll
        for (int ai = 0; ai < 2; ++ai)
#pragma unroll
            for (int m = 0; m < 4; ++m) { const int row = rowb + ai * HALF + m * 16;
#pragma unroll
                for (int bj = 0; bj < 2; ++bj) *(u32x4*)((unsigned char*)O + tiled_off(row, 2 * (colb + HALF * bj), 2 * ldc)) = pack8(acc[ai][bj][m][0], acc[ai][bj][m][1]); }
    }
};
struct EpiGateUp {
    static constexpr bool PERM = true, AFTER_DRAIN = false;
    RstdTab rt; unsigned char* ACT;
    __device__ __forceinline__ void operator()(const f32x4 (&acc)[2][2][4][2], const Unit& u, int wr, int wc, int fr, int fq) const {
        asm volatile("" : "+v"(fr), "+v"(fq));
        const int rowb = u.pm * BM + wr * 64 + fr;
        float rs[2][4]; epi_rstd(rt, u.pm, wr * 64 + fr, rs);
        const int cb = 128 * u.pn + wc * 32 + 8 * fq; const bool f8t = 128 * u.pn < DOWN_K8;
        const int bc = f8t ? cb : DOWN_K8 + 2 * (cb - DOWN_K8);
#pragma unroll
        for (int ai = 0; ai < 2; ++ai)
#pragma unroll
            for (int m = 0; m < 4; ++m) { const int row = rowb + ai * HALF + m * 16; const float r = rs[ai][m];
                const float nrl = r * -1.4426950408889634f, r2 = r * r;
                const f32x4 ga = acc[ai][0][m][0], gb = acc[ai][0][m][1];
                const f32x4 ea = ga * nrl, eb = gb * nrl;
                const f32x4 da = (f32x4){__builtin_amdgcn_exp2f(ea[0]), __builtin_amdgcn_exp2f(ea[1]), __builtin_amdgcn_exp2f(ea[2]), __builtin_amdgcn_exp2f(ea[3])} + 1.0f;
                const f32x4 db = (f32x4){__builtin_amdgcn_exp2f(eb[0]), __builtin_amdgcn_exp2f(eb[1]), __builtin_amdgcn_exp2f(eb[2]), __builtin_amdgcn_exp2f(eb[3])} + 1.0f;
                const f32x4 ia = (f32x4){__builtin_amdgcn_rcpf(da[0]), __builtin_amdgcn_rcpf(da[1]), __builtin_amdgcn_rcpf(da[2]), __builtin_amdgcn_rcpf(da[3])} * r2;
                const f32x4 ib = (f32x4){__builtin_amdgcn_rcpf(db[0]), __builtin_amdgcn_rcpf(db[1]), __builtin_amdgcn_rcpf(db[2]), __builtin_amdgcn_rcpf(db[3])} * r2;
                const f32x4 va = (ga * acc[ai][1][m][0]) * ia, vb = (gb * acc[ai][1][m][1]) * ib;
                unsigned char* const O = ACT + tiled_off(row, bc, ACT_ROW_BYTES);
                if (f8t) *(u32x2_*)O = pack8_fp8(va, vb); else *(u32x4*)O = pack8(va, vb); }
    }
};
__device__ __forceinline__ f32x4 unpk_lo(const u32x4 w) { return (f32x4){__builtin_bit_cast(float, w.x << 16), __builtin_bit_cast(float, w.x & 0xffff0000u), __builtin_bit_cast(float, w.y << 16), __builtin_bit_cast(float, w.y & 0xffff0000u)}; }
__device__ __forceinline__ f32x4 unpk_hi(const u32x4 w) { return (f32x4){__builtin_bit_cast(float, w.z << 16), __builtin_bit_cast(float, w.z & 0xffff0000u), __builtin_bit_cast(float, w.w << 16), __builtin_bit_cast(float, w.w & 0xffff0000u)}; }
template <int MODE, bool OF32, bool ROWSC = false, bool X8 = false> struct EpiResid {
    static constexpr bool PERM = true, AFTER_DRAIN = false;
    const bf16_t* xin_bf; float* xout_f; bf16_t* xbf; const bf16_t* pj; RstdTab rt; float* part_out; unsigned char* x8;
    __device__ __forceinline__ void operator()(const f32x4 (&acc)[2][2][4][2], const Unit& u, int wr, int wc, int fr, int fq) const {
        asm volatile("" : "+v"(fr), "+v"(fq));
        const int rowb = u.pm * BM + wr * 64 + fr, colb = u.pn * BM + wc * 32 + 8 * fq;
        float rs[2][4];
        if (MODE == 1 || ROWSC) epi_rstd(rt, u.pm, wr * 64 + fr, rs);
        constexpr int PD = 2, NS = PD + 1;
        u32x4 xs[NS][2], ps[NS][2];
#define EPR_ISSUE(rg) do { const int row_ = rowb + ((rg) >> 2) * HALF + ((rg) & 3) * 16; _Pragma("unroll") for (int bj = 0; bj < 2; ++bj) { const size_t o_ = tiled_off(row_, 2 * (colb + HALF * bj), 2048); \
            xs[(rg) % NS][bj] = *(const u32x4*)((const unsigned char*)xin_bf + o_); if (MODE == 1) ps[(rg) % NS][bj] = *(const u32x4*)((const unsigned char*)pj + o_); } } while (0)
#pragma unroll
        for (int rg = 0; rg < PD; ++rg) EPR_ISSUE(rg);
#pragma unroll
        for (int rg = 0; rg < 8; ++rg) { const int ai = rg >> 2, m = rg & 3;
                if (rg + PD < 8) EPR_ISSUE(rg + PD);
                asm volatile("" ::: "memory");
                const int row = rowb + ai * HALF + m * 16; const size_t off = (size_t)row * 1024 + colb; float ss = 0.f;
#pragma unroll
                for (int bj = 0; bj < 2; ++bj) {
                    const size_t offt = tiled_off(row, 2 * (colb + HALF * bj), 2048);
                    const u32x4 xw = xs[rg % NS][bj];
                    const f32x4 x0 = unpk_lo(xw), x1 = unpk_hi(xw);
                    f32x4 o0, o1;
                    if (MODE == 0) { if (ROWSC || X8) { const float r = ROWSC ? rs[ai][m] : (1.0f / W8_SCALE); o0 = x0 + acc[ai][bj][m][0] * r; o1 = x1 + acc[ai][bj][m][1] * r; } else { o0 = x0 + acc[ai][bj][m][0]; o1 = x1 + acc[ai][bj][m][1]; } }
                    else { const u32x4 pw = ps[rg % NS][bj]; const float r = X8 ? rs[ai][m] * (1.0f / W8_SCALE) : rs[ai][m];
                        o0 = x0 + unpk_lo(pw) * sigm4(acc[ai][bj][m][0] * r); o1 = x1 + unpk_hi(pw) * sigm4(acc[ai][bj][m][1] * r); }
                    if (OF32) { *(f32x4*)(xout_f + off + HALF * bj) = o0; *(f32x4*)(xout_f + off + HALF * bj + 4) = o1; }
                    else *(u32x4*)((unsigned char*)xbf + offt) = pack8(o0, o1);
                    if (X8 && MODE == 0) *(u32x2_*)(x8 + tiled_off(row, colb + HALF * bj, 1024)) = pack8_fp8(o0, o1);
                    ss += dot4(o0) + dot4(o1);
                }
                if (!OF32) { ss = xsum_16_32(ss);
                    if (fq == 0) part_out[(size_t)(4 * u.pn + wc) * M + row] = ss; }
                asm volatile("" ::: "memory"); }
#undef EPR_ISSUE
    }
};
template <class Epi, class Sched, bool ALIGN_EPI = false, bool SP2 = false, int F8M = 0, bool ATILED = false>
__device__ __forceinline__ void gemm_phase(PG8_LAS unsigned char* lds, const Gemm g, const Sched& S, const Epi& E, const int tid_in, const TabJob tj = TabJob{nullptr, 0}, const RstdTab tab = RstdTab{-1, -1, -1, -1, nullptr}) {
    int tid_ = tid_in; asm volatile("" : "+v"(tid_));
    const int tid = tid_, wid = __builtin_amdgcn_readfirstlane(tid >> 6), lane = tid & 63, wr = wid >> 2, wc = wid & 3, fr = lane & 15, fq = lane >> 4;
    const int K = g.K, nt = K / BK;
    unsigned voffA[2], voffB[2];
#pragma unroll
    for (int i = 0; i < 2; ++i) { int R, C; stage_rc(tid * 16 + i * 8192, R, C); const int Rb = Epi::PERM ? ((R & ~31) + perm32(R & 31)) : R;
        voffA[i] = ATILED ? (unsigned)tiled_off(R, 2 * C, 2 * K) : (unsigned)(R * K + C) * 2u; voffB[i] = (unsigned)(Rb * K + C) * 2u; }
    const size_t kstep = (size_t)(BK * 2), kstepA = ATILED ? (size_t)2048 : kstep;
    const size_t hstep = (size_t)HALF * K * 2;
    const size_t tstep = 2 * hstep;
    const unsigned ldsw = (unsigned)wid * 1024u;
    const int aoff = lds_byte(wr * 64 + fr, fq * 8), boff = lds_byte(wc * 32 + fr, fq * 8);
#define PG8_SA(b, h) (((b) * 2 + (h)) * HTB)
#define PG8_SB(b, h) ((4 + (b) * 2 + (h)) * HTB)
#define PG8_STAGE(bufoff, gbase, voff) do { _Pragma("unroll") for (int _i = 0; _i < 2; ++_i) \
        __builtin_amdgcn_global_load_lds((const unsigned*)((const char*)(gbase) + (voff)[_i]), (PG8_LAS unsigned*)(lds + (bufoff) + ldsw + _i * 8192), 16, 0, 0); } while (0)
#define PG8_LDA(dst, b, h) do { _Pragma("unroll") for (int m = 0; m < 4; ++m) _Pragma("unroll") for (int k = 0; k < 2; ++k) dst[m][k] = *(const PG8_LAS bf16x8*)(lds + PG8_SA(b, h) + aoff + m * 2048 + k * 1024); } while (0)
#define PG8_LDB(dst, b, h) do { _Pragma("unroll") for (int n = 0; n < 2; ++n) _Pragma("unroll") for (int k = 0; k < 2; ++k) dst[n][k] = *(const PG8_LAS bf16x8*)(lds + PG8_SB(b, h) + boff + n * 2048 + k * 1024); } while (0)
#define PG8_MMA(F8T, ai, bj, At, Bt) do { __builtin_amdgcn_s_setprio(1); _Pragma("unroll") for (int m = 0; m < 4; ++m) _Pragma("unroll") for (int n = 0; n < 2; ++n) { \
        if constexpr (F8T) mfma_f8_acc(acc[ai][bj][m][n], cat8(Bt[n][0], Bt[n][1]), cat8(At[m][0], At[m][1])); \
        else { _Pragma("unroll") for (int k = 0; k < 2; ++k) acc[ai][bj][m][n] = __builtin_amdgcn_mfma_f32_16x16x32_bf16(Bt[n][k], At[m][k], acc[ai][bj][m][n], 0, 0, 0); } } __builtin_amdgcn_s_setprio(0); } while (0)
#define PG8_WAIT_V(n) asm volatile("s_waitcnt vmcnt(" #n ")" ::: "memory")
#define PG8_WAIT_L(n) asm volatile("s_waitcnt lgkmcnt(" #n ")" ::: "memory")
#define PG8_BAR __builtin_amdgcn_s_barrier()
#define PG8_SCHED __builtin_amdgcn_sched_barrier(0)
    Unit cur, nxt; int ui = 0;
    if (!S.next(0, cur)) return;
    f32x4 acc[2][2][4][2];
#pragma unroll
    for (int a = 0; a < 2; ++a)
#pragma unroll
        for (int b = 0; b < 2; ++b)
#pragma unroll
            for (int m = 0; m < 4; ++m)
#pragma unroll
                for (int n = 0; n < 2; ++n) acc[a][b][m][n] = (f32x4){0.f, 0.f, 0.f, 0.f};
    bf16x8 At[4][2], B0[2][2], B1[2][2];
    const char* cA = (const char*)g.A + (size_t)cur.pm * tstep; const char* cB = (const char*)g.Bt + (size_t)cur.pn * tstep;
    S.a_ready(cur);
    if constexpr (SP2) {
        PG8_STAGE(PG8_SB(0, 0), cB, voffB); PG8_STAGE(PG8_SB(0, 1), cB + hstep, voffB); PG8_STAGE(PG8_SA(0, 0), cA, voffA); PG8_STAGE(PG8_SA(0, 1), cA + hstep, voffA);
        if (tj.mode) table_fill(tab, tj, tid);
        if (wr == 1) PG8_BAR;
        PG8_WAIT_V(2); PG8_BAR;
        PG8_STAGE(PG8_SB(1, 0), cB + kstep, voffB); PG8_STAGE(PG8_SA(1, 0), cA + kstepA, voffA); PG8_STAGE(PG8_SB(1, 1), cB + hstep + kstep, voffB);
        PG8_WAIT_V(6); PG8_BAR;
    } else {
        PG8_STAGE(PG8_SB(0, 0), cB, voffB); PG8_STAGE(PG8_SA(0, 0), cA, voffA); PG8_STAGE(PG8_SB(0, 1), cB + hstep, voffB); PG8_STAGE(PG8_SA(0, 1), cA + hstep, voffA);
        if (wr == 1) PG8_BAR;
        PG8_WAIT_V(4); PG8_BAR;
        PG8_STAGE(PG8_SB(1, 0), cB + kstep, voffB); PG8_STAGE(PG8_SA(1, 0), cA + kstepA, voffA); PG8_STAGE(PG8_SB(1, 1), cB + hstep + kstep, voffB);
        PG8_WAIT_V(6); PG8_BAR;
    }
    for (;;) {
        const bool has_next = S.next(ui + 1, nxt);
        const char* nA = has_next ? (const char*)g.A + (size_t)nxt.pm * tstep : cA; const char* nB = has_next ? (const char*)g.Bt + (size_t)nxt.pn * tstep : cB;
        auto kpair = [&](auto f8t_, const int t) __attribute__((always_inline)) { constexpr bool F8T = decltype(f8t_)::value;
            const bool last = (t == nt - 2);
            const char* a1 = cA + (size_t)(t + 1) * kstepA;
            const char* a2 = last ? nA : cA + (size_t)(t + 2) * kstepA; const char* b2 = last ? nB : cB + (size_t)(t + 2) * kstep;
            const char* a3 = a2 + kstepA; const char* b3 = b2 + kstep;
            if (last && has_next) S.a_ready(nxt);
            if constexpr (SP2) {
            PG8_LDB(B0, 0, 0); PG8_LDB(B1, 0, 1); PG8_SCHED; PG8_LDA(At, 0, 0); PG8_STAGE(PG8_SA(1, 1), a1 + hstep, voffA);
            PG8_WAIT_V(8); PG8_WAIT_L(0); PG8_BAR; PG8_MMA(F8T, 0, 0, At, B0); PG8_MMA(F8T, 0, 1, At, B1); PG8_BAR; PG8_SCHED;
            PG8_LDA(At, 0, 1); PG8_STAGE(PG8_SB(0, 0), b2, voffB); PG8_STAGE(PG8_SB(0, 1), b2 + hstep, voffB); PG8_STAGE(PG8_SA(0, 0), a2, voffA);
            PG8_WAIT_V(8); PG8_WAIT_L(0); PG8_BAR; PG8_MMA(F8T, 1, 0, At, B0); PG8_MMA(F8T, 1, 1, At, B1); PG8_BAR; PG8_SCHED;
            PG8_LDB(B0, 1, 0); PG8_LDB(B1, 1, 1); PG8_SCHED; PG8_LDA(At, 1, 0); PG8_STAGE(PG8_SA(0, 1), a2 + hstep, voffA);
            PG8_WAIT_V(8); PG8_WAIT_L(0); PG8_BAR; PG8_MMA(F8T, 0, 0, At, B0); PG8_MMA(F8T, 0, 1, At, B1); PG8_BAR; PG8_SCHED;
            PG8_LDA(At, 1, 1); PG8_STAGE(PG8_SB(1, 0), b3, voffB); PG8_STAGE(PG8_SB(1, 1), b3 + hstep, voffB); PG8_STAGE(PG8_SA(1, 0), a3, voffA);
            PG8_WAIT_V(8); PG8_WAIT_L(0); PG8_BAR; PG8_MMA(F8T, 1, 0, At, B0); PG8_MMA(F8T, 1, 1, At, B1); PG8_BAR; PG8_SCHED;
            } else {
            PG8_LDB(B0, 0, 0); PG8_SCHED; PG8_LDA(At, 0, 0); PG8_STAGE(PG8_SA(1, 1), a1 + hstep, voffA);
            PG8_WAIT_L(8); PG8_BAR; PG8_WAIT_L(0); PG8_MMA(F8T, 0, 0, At, B0); PG8_BAR; PG8_SCHED;
            PG8_LDB(B1, 0, 1); PG8_STAGE(PG8_SB(0, 0), b2, voffB);
            PG8_BAR; PG8_WAIT_L(0); PG8_MMA(F8T, 0, 1, At, B1); PG8_BAR;
            PG8_LDA(At, 0, 1); PG8_STAGE(PG8_SA(0, 0), a2, voffA);
            PG8_BAR; PG8_WAIT_L(0); PG8_MMA(F8T, 1, 0, At, B0); PG8_BAR; PG8_SCHED;
            PG8_STAGE(PG8_SB(0, 1), b2 + hstep, voffB);
            PG8_WAIT_V(6); PG8_BAR; PG8_MMA(F8T, 1, 1, At, B1); PG8_BAR;
            PG8_LDB(B0, 1, 0); PG8_SCHED; PG8_LDA(At, 1, 0); PG8_STAGE(PG8_SA(0, 1), a2 + hstep, voffA);
            PG8_WAIT_L(8); PG8_BAR; PG8_WAIT_L(0); PG8_MMA(F8T, 0, 0, At, B0); PG8_BAR; PG8_SCHED;
            PG8_LDB(B1, 1, 1); PG8_STAGE(PG8_SB(1, 0), b3, voffB);
            PG8_BAR; PG8_WAIT_L(0); PG8_MMA(F8T, 0, 1, At, B1); PG8_BAR;
            PG8_LDA(At, 1, 1); PG8_STAGE(PG8_SA(1, 0), a3, voffA);
            PG8_BAR; PG8_WAIT_L(0); PG8_MMA(F8T, 1, 0, At, B0); PG8_BAR; PG8_SCHED;
            PG8_STAGE(PG8_SB(1, 1), b3 + hstep, voffB);
            PG8_WAIT_V(6); PG8_BAR; PG8_MMA(F8T, 1, 1, At, B1); PG8_BAR;
            }
        };
        if constexpr (F8M == 1) { for (int t = 0; t < nt; t += 2) kpair(std::true_type{}, t); }
        else if constexpr (F8M == 2) { int t = 0; for (; t < g.nt8; t += 2) kpair(std::true_type{}, t); for (; t < nt; t += 2) kpair(std::false_type{}, t); }
        else { for (int t = 0; t < nt; t += 2) kpair(std::false_type{}, t); }
        if constexpr (F8M == 1) asm volatile("s_nop 15\n\ts_nop 7" ::: "memory");
        if constexpr (ALIGN_EPI) { if (wr == 0) PG8_BAR; }
        if constexpr (!Epi::AFTER_DRAIN) { E(acc, cur, wr, wc, fr, fq); S.done(cur); }
        if (!has_next) break;
#pragma unroll
        for (int a = 0; a < 2; ++a)
#pragma unroll
            for (int b = 0; b < 2; ++b)
#pragma unroll
                for (int m = 0; m < 4; ++m)
#pragma unroll
                    for (int n = 0; n < 2; ++n) acc[a][b][m][n] = (f32x4){0.f, 0.f, 0.f, 0.f};
        cur = nxt; cA = nA; cB = nB; ++ui;
        if constexpr (ALIGN_EPI) { if (wr == 1) PG8_BAR; }
    }
    PG8_WAIT_V(0);
    if constexpr (!ALIGN_EPI) { if (wr == 0) PG8_BAR; }
    PG8_BAR;
    if constexpr (Epi::AFTER_DRAIN) { E.fused(acc, cur, wr, wc, fr, fq, lds, wid, lane); S.done(cur); }
#undef PG8_SA
#undef PG8_SB
#undef PG8_STAGE
#undef PG8_LDA
#undef PG8_LDB
#undef PG8_MMA
#undef PG8_WAIT_V
#undef PG8_WAIT_L
#undef PG8_BAR
#undef PG8_SCHED
}
}

constexpr int NWAVES = 8;
constexpr int RING_BYTES = 131072, LDS_BYTES = 163840, LDSCTL_OFF = LDS_BYTES - 1024, MISC_OFF = LDSCTL_OFF + 320;

struct Args { const void* in[N_IN]; float* out; unsigned char* ws; int st_lo, st_hi, li, pad; };

struct Ctx {
    const Args* a; unsigned char* ws; float* out;
    int tid, lane, wave, gw, ngw, gtid, ngt;
    LAS unsigned char* lds;
    __device__ __forceinline__ const float* fin(int i, size_t off = 0) const { return (const float*)a->in[i] + off; }
};

__device__ __forceinline__ void dsincos(double r, double& s, double& c) {
    const double r2 = r * r;
    double ts = 1.0, tc = 1.0;
#pragma unroll
    for (int k = 14; k >= 1; --k) { ts = 1.0 - ts * r2 * (1.0 / (double)((2 * k) * (2 * k + 1))); tc = 1.0 - tc * r2 * (1.0 / (double)((2 * k - 1) * (2 * k))); }
    s = r * ts; c = tc;
}
__device__ __forceinline__ void step_prologue(const Ctx& C) {
    {
        const float* x = C.fin(I_X);
        bf16* xbf = (bf16*)(C.ws + WS_XBF); float* part = (float*)(C.ws + WS_PARTA);
        constexpr int RPW = 4;
        for (int m0 = C.gw * RPW; m0 < M; m0 += C.ngw * RPW) {
            f32x4 v[RPW][4]; float srow = 0.f;
#pragma unroll
            for (int r = 0; r < RPW; ++r)
#pragma unroll
                for (int j = 0; j < 4; ++j) v[r][j] = *((const f32x4*)(x + (size_t)(m0 + r) * D_MODEL) + C.lane + 64 * j);
#pragma unroll
            for (int r = 0; r < RPW; ++r) {
                float s = 0.f;
#pragma unroll
                for (int j = 0; j < 4; ++j) { const f32x4 t = v[r][j]; s += (t.x * t.x + t.y * t.y) + (t.z * t.z + t.w * t.w); u32x2 w; w.x = pk2(t.x, t.y); w.y = pk2(t.z, t.w); *(u32x2*)((unsigned char*)xbf + tiled_off(m0 + r, 8 * (C.lane + 64 * j), 2 * D_MODEL)) = w; }
                s = wave_sum(s); srow = (C.lane == r) ? s : srow;
            }
            if (C.lane < RPW) part[m0 + C.lane] = srow;
        }
    }
    {
        const f32x4* p4 = (const f32x4*)C.fin(I_P); u32x2* o = (u32x2*)(C.ws + WS_PBF);
        constexpr size_t n4 = (size_t)DEPTH * M * PLE_DIM / 4;
        for (size_t i0 = C.gtid; i0 < n4; i0 += (size_t)C.ngt * 8) {
            f32x4 v[8];
#pragma unroll
            for (int k = 0; k < 8; ++k) { const size_t i = i0 + (size_t)k * C.ngt; v[k] = p4[i < n4 ? i : n4 - 1]; }
#pragma unroll
            for (int k = 0; k < 8; ++k) { const size_t i = i0 + (size_t)k * C.ngt; if (i < n4) { u32x2 w; w.x = pk2(v[k].x, v[k].y); w.y = pk2(v[k].z, v[k].w); o[i] = w; } }
        }
    }
    {
        const int* pos = (const int*)C.a->in[I_POS]; float* ct = (float*)(C.ws + WS_COS); float* st = (float*)(C.ws + WS_SIN);
        const float invf[8] = {1.0f, 0.1939227432012558f, 0.03760603070259094f, 0.007292664609849453f, 0.0014142135623842478f, 0.00027424818836152554f, 5.318296098266728e-05f, 1.0313386155758053e-05f};
        for (int i = C.gtid; i < M * 8; i += C.ngt) {
            const int m = i >> 3, j = i & 7;
            float fr = 1.0f;
#pragma unroll
            for (int q = 0; q < 8; ++q) fr = (j == q) ? invf[q] : fr;
            const float ang = (float)pos[m] * fr;
            const double a = (double)ang, k = __builtin_rint(a * 0.15915494309189535);
            const double r = (a - k * 6.283185307179586) - k * 2.4492935982947064e-16;
            double s, c; dsincos(r, s, c);
            ct[i] = (float)c; st[i] = (float)s;
        }
    }
}

__device__ __forceinline__ int dperm16(int e) { return (e < 16) ? (8 * ((e >> 2) & 1) + 4 * (e >> 3) + (e & 3)) : e; }
template <bool F8 = false>
__device__ __forceinline__ void wprep_item(const float* __restrict__ W, int ldw, const float* __restrict__ gain, unsigned char* WT, size_t rowbytes, int kbyte0, float scale, int k0, int nsrc0, int drow0, bool permq, LAS float* scr, int lane) {
    float wv[32];
#pragma unroll
    for (int i = 0; i < 32; ++i) { const int kk = 2 * i + (lane >> 5); wv[i] = W[(size_t)(k0 + kk) * ldw + nsrc0 + (lane & 31)]; }
#pragma unroll
    for (int i = 0; i < 32; ++i) { const int kk = 2 * i + (lane >> 5); const float g = gain ? gain[k0 + kk] * scale : scale; scr[kk * 33 + (lane & 31)] = wv[i] * g; }
    asm volatile("s_waitcnt lgkmcnt(0)" ::: "memory");
    const int c = lane & 7;
#pragma unroll
    for (int j = 0; j < 4; ++j) { const int e = (lane >> 3) + 8 * j, sc = permq ? dperm16(e) : e; const LAS float* sp = scr + (8 * c) * 33 + sc;
        unsigned char* dst = WT + (size_t)(drow0 + e) * rowbytes + kbyte0;
        if constexpr (F8) *(u32x2*)(dst + 8 * c) = pg8::pack8_fp8((f32x4){sp[0 * 33], sp[1 * 33], sp[2 * 33], sp[3 * 33]}, (f32x4){sp[4 * 33], sp[5 * 33], sp[6 * 33], sp[7 * 33]});
        else { u32x4 o; o.x = pk2(sp[0 * 33], sp[1 * 33]); o.y = pk2(sp[2 * 33], sp[3 * 33]); o.z = pk2(sp[4 * 33], sp[5 * 33]); o.w = pk2(sp[6 * 33], sp[7 * 33]);
            *(u32x4*)(dst + 16 * c) = o; } }
    asm volatile("s_waitcnt lgkmcnt(0)" ::: "memory");
}
__device__ __forceinline__ void inproj_src(int gi, int& nsrc0, bool& permq) {
    const int c0 = 32 * gi, pn = c0 >> 8, r = c0 & 255, bj = r >> 7, wc = (r >> 5) & 3;
    permq = false;
    if (pn < 2) { nsrc0 = Q_OFF + 64 * (4 * pn + wc) + 32 * bj; permq = (bj == 0); }
    else if (pn == 2) { if (wc < 2) { nsrc0 = K_OFF + 64 * wc + 32 * bj; permq = (bj == 0); } else nsrc0 = V_OFF + 64 * (wc - 2) + 32 * bj; }
    else if (pn == 3) nsrc0 = GM_OFF + r;
    else if (pn == 4) nsrc0 = GM_OFF + 256 + r;
    else nsrc0 = CONV_OFF + 256 * bj + 128 * (pn - 5) + 32 * wc;
}
__device__ __forceinline__ void step_wprep(const Ctx& C) {
    LAS float* scr = (LAS float*)(C.lds + C.wave * 16384);
    constexpr int I_IN = 16 * (IN_COLS / 32), I_OUT = 16 * 32, I_GU = 16 * (2 * D_FF / 32), I_DOWN = (D_FF / 64) * 32, I_PG = 16 * 32, I_PP = 4 * 32, I_LAYER = I_IN + I_OUT + I_GU + I_DOWN + I_PG + I_PP;
    for (int it = C.gw; it < DEPTH * I_LAYER; it += C.ngw) {
        const int l = it / I_LAYER; int r = it % I_LAYER;
        bf16* WL = (bf16*)(C.ws + WS_W + (size_t)l * W_LAYER);
        if (r < I_IN) { const int gi = r % (IN_COLS / 32), kb = r / (IN_COLS / 32); int ns; bool pq; inproj_src(gi, ns, pq);
            wprep_item(C.fin(I_W_IN, (size_t)l * D_MODEL * IN_COLS), IN_COLS, C.fin(I_NORM_MIX_G, (size_t)l * D_MODEL), (unsigned char*)WL + WO_IN, D_MODEL * 2, 128 * kb, 1.0f, 64 * kb, ns, 32 * gi, pq, scr, C.lane); continue; } r -= I_IN;
        if (r < I_OUT) { const int gi = r % 32, kb = r / 32;
            wprep_item(C.fin(I_W_OUT, (size_t)l * D_MODEL * D_MODEL), D_MODEL, C.fin(I_OUT_NORM_G, (size_t)l * D_MODEL), (unsigned char*)WL + WO_OUT, D_MODEL * 2, 128 * kb, 1.0f, 64 * kb, 32 * gi, 32 * gi, false, scr, C.lane); continue; } r -= I_OUT;
        if (r < I_GU) { const int gi = r % (2 * D_FF / 32), kb = r / (2 * D_FF / 32); const int c0 = 32 * gi, pn = c0 >> 8, rr = c0 & 255, bj = rr >> 7;
            wprep_item(C.fin(I_W_GU, (size_t)l * D_MODEL * 2 * D_FF), 2 * D_FF, C.fin(I_NORM_FFN_G, (size_t)l * D_MODEL), (unsigned char*)WL + WO_GU, D_MODEL * 2, 128 * kb, 1.0f, 64 * kb, bj * D_FF + 128 * pn + (rr & 127), 32 * gi, false, scr, C.lane); continue; } r -= I_GU;
        if (r < I_DOWN) { const int gi = r % 32, kb = r / 32;
            if (64 * kb < DOWN_K8) wprep_item<true>(C.fin(I_W_DOWN, (size_t)l * D_FF * D_MODEL), D_MODEL, nullptr, (unsigned char*)WL + WO_DOWN, ACT_ROW_BYTES, 64 * kb, pg8::W8_SCALE, 64 * kb, 32 * gi, 32 * gi, false, scr, C.lane);
            else wprep_item(C.fin(I_W_DOWN, (size_t)l * D_FF * D_MODEL), D_MODEL, nullptr, (unsigned char*)WL + WO_DOWN, ACT_ROW_BYTES, DOWN_K8 + 2 * (64 * kb - DOWN_K8), pg8::W8_SCALE, 64 * kb, 32 * gi, 32 * gi, false, scr, C.lane); continue; } r -= I_DOWN;
        if (r < I_PG) { const int gi = r % 32, kb = r / 32;
            wprep_item<true>(C.fin(I_W_PG, (size_t)l * D_MODEL * D_MODEL), D_MODEL, C.fin(I_PLE_NORM_G, (size_t)l * D_MODEL), (unsigned char*)WL + WO_PG, D_MODEL, 64 * kb, pg8::W8_SCALE, 64 * kb, 32 * gi, 32 * gi, false, scr, C.lane); continue; } r -= I_PG;
        { const int gi = r % 32, kb = r / 32;
            wprep_item(C.fin(I_W_PP, (size_t)l * PLE_DIM * D_MODEL), D_MODEL, nullptr, (unsigned char*)WL + WO_PP, PLE_DIM * 2, 128 * kb, 1.0f, 64 * kb, 32 * gi, 32 * gi, false, scr, C.lane); }
    }
    {
        const f32x4* w4 = (const f32x4*)C.fin(I_GM_WS); u32x2* o = (u32x2*)(C.ws + WS_WSBF);
        for (int i = C.gtid; i < DEPTH * GM_HEADS * CHUNK * CHUNK / 4; i += C.ngt) { const f32x4 v = w4[i]; u32x2 w; w.x = pk2(v.x, v.y); w.y = pk2(v.z, v.w); o[i] = w; }
    }
}

__device__ __forceinline__ const pg8::bf16_t* wcopy(const Ctx& C, int l, size_t off) { return (const pg8::bf16_t*)(C.ws + WS_W + (size_t)l * W_LAYER + off); }
struct PjOrder {
    int c, G;
    __device__ __forceinline__ bool next(int i, pg8::Unit& u) const {
        constexpr int NU = (M / 256) * (D_MODEL / 256);
        if (G == 256) { if (c < 128) { if (i >= 1) return false; u.pm = c; u.pn = 3; return true; } if (i >= 3) return false; u.pm = c - 128; u.pn = i; return true; }
        const int L = i * G + c; if (L >= NU) return false; u.pm = L >> 2; u.pn = L & 3; return true;
    }
    __device__ __forceinline__ void a_ready(const pg8::Unit&) const {}
    __device__ __forceinline__ void done(const pg8::Unit&) const {}
};
__device__ __forceinline__ void step_inproj_opt(const Ctx& C, int l, const float* part) {
    {
        pg8::Gemm g{(const pg8::bf16_t*)(C.ws + (l == 0 ? WS_XBF : WS_XBF2)), wcopy(C, l, WO_IN), M, IN_COLS, D_MODEL};
        pg8::StaticOrder S; S.init(M, IN_COLS, (int)gridDim.x, (int)blockIdx.x);
        const pg8::RstdTab rt = pg8::table_slots(C.lds, S); const pg8::TabJob tj{part, l == 0 ? 2 : 1};
        pg8::EpiInProj E{rt, C.ws, WS_Q, WS_K, WS_V, WS_U, WS_VV, WS_GLU, WS_COS, WS_SIN, C.fin(I_QG, l * 64), C.fin(I_KG, l * 64), C2};
        pg8::gemm_phase<pg8::EpiInProj, pg8::StaticOrder, true, true, 0, true>(C.lds, g, S, E, C.tid, tj, rt);
    }
    {
        pg8::Gemm g{(const pg8::bf16_t*)(C.ws + WS_PBF) + (size_t)l * M * PLE_DIM, wcopy(C, l, WO_PP), M, D_MODEL, PLE_DIM};
        PjOrder S; S.c = (int)blockIdx.x; S.G = (int)gridDim.x;
        pg8::EpiStore E{(pg8::bf16_t*)(C.ws + WS_PJ), D_MODEL};
        pg8::gemm_phase<pg8::EpiStore, PjOrder, false, true>(C.lds, g, S, E, C.tid);
    }
}
template <int MODE, bool OF32, bool ROWSC = false, bool X8 = false>
__device__ __forceinline__ void step_resid_opt(const Ctx& C, const bf16* A, int K, const pg8::bf16_t* Bt, const bf16* xin_bf, bf16* xbf_out, const float* part_in, float* part_out) {
    pg8::Gemm g{(const pg8::bf16_t*)A, Bt, M, D_MODEL, K};
    pg8::StaticOrder S; S.init(M, D_MODEL, (int)gridDim.x, (int)blockIdx.x);
    pg8::RstdTab rt; rt.pm0 = rt.pm1 = rt.pm2 = rt.pm3 = -1; rt.lds = C.lds; pg8::TabJob tj{nullptr, 0};
    if (MODE == 1) { rt = pg8::table_slots(C.lds, S); tj = pg8::TabJob{part_in, 1}; }
    if (ROWSC) { rt = pg8::table_slots(C.lds, S); tj = pg8::TabJob{(const float*)(C.ws + WS_ARSTD), 3}; }
    pg8::EpiResid<MODE, OF32, ROWSC, X8> E{(const pg8::bf16_t*)xin_bf, C.out, (pg8::bf16_t*)xbf_out, (const pg8::bf16_t*)(C.ws + WS_PJ), rt, part_out, C.ws + WS_X8};
    constexpr int F8M = X8 ? (MODE == 1 ? 1 : 2) : 0;
    if (F8M == 2) g.nt8 = DOWN_K8 / 128;
    pg8::gemm_phase<pg8::EpiResid<MODE, OF32, ROWSC, X8>, pg8::StaticOrder, true, true, F8M, X8>(C.lds, g, S, E, C.tid, tj, rt);
}
__device__ __forceinline__ void step_gateup_opt(const Ctx& C, int l, const float* part) {
    pg8::Gemm g{(const pg8::bf16_t*)(C.ws + WS_XBF), wcopy(C, l, WO_GU), M, 2 * D_FF, D_MODEL};
    pg8::StaticOrder S; S.init(M, 2 * D_FF, (int)gridDim.x, (int)blockIdx.x);
    const pg8::RstdTab rt = pg8::table_slots(C.lds, S); const pg8::TabJob tj{part, 1};
    pg8::EpiGateUp E{rt, C.ws + WS_ACT};
    pg8::gemm_phase<pg8::EpiGateUp, pg8::StaticOrder, true, true, 0, true>(C.lds, g, S, E, C.tid, tj, rt);
}


typedef short bf16x8_t __attribute__((ext_vector_type(8)));
__device__ __forceinline__ f32x4 mfma16(const bf16x8_t a, const bf16x8_t b, const f32x4 c) { return __builtin_amdgcn_mfma_f32_16x16x32_bf16(a, b, c, 0, 0, 0); }
__device__ __forceinline__ unsigned cvtpk(float lo, float hi) { unsigned r; asm volatile("s_nop 1\n\tv_cvt_pk_bf16_f32 %0, %1, %2" : "=v"(r) : "v"(lo), "v"(hi)); return r; }
__device__ __forceinline__ u32x2 cvtpk2(const f32x4 p) { u32x2 r; asm volatile("s_nop 1\n\tv_cvt_pk_bf16_f32 %0, %2, %3\n\tv_cvt_pk_bf16_f32 %1, %4, %5" : "=&v"(r.x), "=&v"(r.y) : "v"(p.x), "v"(p.y), "v"(p.z), "v"(p.w)); return r; }
__device__ __forceinline__ float rsq_(float x) { return __builtin_amdgcn_rsqf(x); }
constexpr int CV_G = 0, CV_GROW = 512, CV_Y = 49152, CV_YROW = 1024, CV_W = 114688;
static_assert(CV_W + CONV_W * CONV_CH * 4 <= LDSCTL_OFF, "conv scratch below the LDS control words");
constexpr int GM_T = 0, GM_TROW = 272, GM_ST = 69632;
constexpr int AT_K = 0, AT_KROW = 128, AT_V = 49152, AT_VROW = 904, AT_O = 107008, AT_OROW = 272;
constexpr int MX_RA = 162304;
static_assert(AT_O + NWAVES * 16 * AT_OROW <= MX_RA && MX_RA + 512 <= LDSCTL_OFF, "mixer LDS map");
constexpr int AT_K_ = 0;
__device__ __forceinline__ void step_mixer_opt(const Ctx& C, int l) {
    const int w = C.wave;
    LAS unsigned char* const L = C.lds;
#define MIX_LANES() int tid = w * 64 + lane_id(); asm volatile("" : "+v"(tid)); const int lane = tid & 63, l15 = lane & 15, h4 = lane >> 4; (void)l15; (void)h4
    bf16* const MG = (bf16*)(C.ws + WS_MERGED);
    for (int rep_mix = 0; rep_mix < REP_MIX; ++rep_mix)
    for (int unit = blockIdx.x; unit < M / CHUNK; unit += gridDim.x) {
        const int m0 = unit * CHUNK, tpos0 = m0 & (SEQ - 1);
        {
            MIX_LANES();
            const bf16* Q = (const bf16*)(C.ws + WS_Q); const bf16* Kb = (const bf16*)(C.ws + WS_K); const bf16* V = (const bf16*)(C.ws + WS_V);
            const float* sink = C.fin(I_SINK, l * NQH);
            const int cidx = tpos0 >> 7;
            const bool edge = (cidx == 0) || (cidx == SEQ / CHUNK - 1);
            const int kb_lo = (cidx == 0) ? 8 - w : 0, kb_hi = (cidx == SEQ / CHUNK - 1) ? 16 - w : 17;
            const size_t qrow = (size_t)(m0 + 16 * w + l15);
            float ssq = 0.f;
            float bref; { const float gq = fabsf(C.fin(I_QG, l * 64)[lane]), gk = fabsf(C.fin(I_KG, l * 64)[lane]);
                float a = gq, b = gk;
                a = fmaxf(a, dpp_(a, 0xB1, 0xf, true)); a = fmaxf(a, dpp_(a, 0x4E, 0xf, true)); a = fmaxf(a, dpp_(a, 0x141, 0xf, true)); a = fmaxf(a, dpp_(a, 0x140, 0xf, true)); a = xmax_16_32(a);
                b = fmaxf(b, dpp_(b, 0xB1, 0xf, true)); b = fmaxf(b, dpp_(b, 0x4E, 0xf, true)); b = fmaxf(b, dpp_(b, 0x141, 0xf, true)); b = fmaxf(b, dpp_(b, 0x140, 0xf, true)); b = xmax_16_32(b);
                bref = __builtin_bit_cast(float, __builtin_amdgcn_readfirstlane(__builtin_bit_cast(int, 64.0f * C2 * 1.02f * a * b))); }
            const bool fast_ref = bref <= 32.0f;
            const f32x4 negB = (f32x4){-bref, -bref, -bref, -bref};
            const bf16x8_t ones8 = (bf16x8_t){(short)0x3f80, (short)0x3f80, (short)0x3f80, (short)0x3f80, (short)0x3f80, (short)0x3f80, (short)0x3f80, (short)0x3f80};
#pragma unroll 1
            for (int g = 0; g < 2; ++g) {
                {
                    u32x4 kq[6], vq[6];
#pragma unroll
                    for (int it = 0; it < 6; ++it) {
                        const int i = tid + it * (NWAVES * 64);
                        { const int R = i >> 3, ch = i & 7, tp = tpos0 - WINDOW + R, tpc = tp < 0 ? 0 : (tp > SEQ - 1 ? SEQ - 1 : tp);
                          kq[it] = *(const u32x4*)(Kb + (size_t)(m0 - tpos0 + tpc) * 128 + 64 * g + 8 * ch); if (tp != tpc) kq[it] = (u32x4){0u, 0u, 0u, 0u}; }
                        { const int R = i % 384, ch = i / 384, tp = tpos0 - WINDOW + R, tpc = tp < 0 ? 0 : (tp > SEQ - 1 ? SEQ - 1 : tp);
                          vq[it] = *(const u32x4*)(V + (size_t)(m0 - tpos0 + tpc) * 128 + 64 * g + 8 * ch); if (tp != tpc) vq[it] = (u32x4){0u, 0u, 0u, 0u}; }
                    }
#pragma unroll
                    for (int it = 0; it < 6; ++it) {
                        const int i = tid + it * (NWAVES * 64);
                        { const int R = i >> 3, ch = i & 7; *(LAS u32x4*)(L + AT_K + R * AT_KROW + ((ch ^ (R & 7)) * 16)) = kq[it]; }
                        { const int R = i % 384, ch = i / 384;
                          LAS unsigned short* vp = (LAS unsigned short*)(L + AT_V + (8 * ch) * AT_VROW + R * 2); const u32x4 vv = vq[it];
                          vp[0 * (AT_VROW / 2)] = (unsigned short)(vv.x & 0xffffu); vp[1 * (AT_VROW / 2)] = (unsigned short)(vv.x >> 16);
                          vp[2 * (AT_VROW / 2)] = (unsigned short)(vv.y & 0xffffu); vp[3 * (AT_VROW / 2)] = (unsigned short)(vv.y >> 16);
                          vp[4 * (AT_VROW / 2)] = (unsigned short)(vv.z & 0xffffu); vp[5 * (AT_VROW / 2)] = (unsigned short)(vv.z >> 16);
                          vp[6 * (AT_VROW / 2)] = (unsigned short)(vv.w & 0xffffu); vp[7 * (AT_VROW / 2)] = (unsigned short)(vv.w >> 16); }
                    }
                }
                for (int i = tid; i < 64 * 24; i += NWAVES * 64) *(LAS unsigned short*)(L + AT_V + (i / 24) * AT_VROW + (384 + i % 24) * 2) = (unsigned short)0;
                __syncthreads();
                if (w >= 4) __builtin_amdgcn_s_sleep(ATT_STAGGER);
                auto head_pairs = [&](auto fast_tag) {
                constexpr bool FAST = decltype(fast_tag)::value;
#pragma unroll 1
                for (int hp = 0; hp < 2; ++hp) {
                    const int hA = 4 * g + 2 * hp;
                    bf16x8_t qA[2], qB[2];
#pragma unroll
                    for (int s2 = 0; s2 < 2; ++s2) { qA[s2] = *(const bf16x8_t*)(Q + qrow * 512 + 64 * hA + 32 * s2 + 8 * h4); qB[s2] = *(const bf16x8_t*)(Q + qrow * 512 + 64 * hA + 64 + 32 * s2 + 8 * h4); }
                    f32x4 sA[17], sB[17];
#pragma unroll
                    for (int kb = 0; kb < 17; ++kb) {
                        const LAS unsigned char* kp = L + AT_K + (16 * (w + kb) + l15) * AT_KROW;
                        const bf16x8_t k0 = *(const LAS bf16x8_t*)(kp + ((h4 ^ (l15 & 7)) * 16)), k1 = *(const LAS bf16x8_t*)(kp + (((4 + h4) ^ (l15 & 7)) * 16));
                        f32x4 a = FAST ? negB : (f32x4){0.f, 0.f, 0.f, 0.f}, b = a;
                        a = mfma16(k0, qA[0], a); b = mfma16(k0, qB[0], b); a = mfma16(k1, qA[1], a); b = mfma16(k1, qB[1], b);
                        sA[kb] = a; sB[kb] = b;
                    }
                    __builtin_amdgcn_sched_barrier(0);
                    const float NEG = -1e30f;
                    if (edge) {
#pragma unroll
                        for (int kb = 0; kb < 17; ++kb) if (kb < kb_lo || kb >= kb_hi) { sA[kb] = (f32x4){NEG, NEG, NEG, NEG}; sB[kb] = (f32x4){NEG, NEG, NEG, NEG}; }
                    }
#pragma unroll
                    for (int i = 0; i < 4; ++i) { if (4 * h4 + i < l15) { sA[0][i] = NEG; sB[0][i] = NEG; } if (4 * h4 + i > l15) { sA[16][i] = NEG; sB[16][i] = NEG; } }
                    const float skA = sink[hA] * LOG2E, skB = sink[hA + 1] * LOG2E;
                    float mxA = 0.f, mxB = 0.f;
                    if (!FAST) {
                        mxA = skA; mxB = skB;
#pragma unroll
                        for (int kb = 0; kb < 17; ++kb) { mxA = fmaxf(fmaxf(mxA, fmaxf(sA[kb].x, sA[kb].y)), fmaxf(sA[kb].z, sA[kb].w)); mxB = fmaxf(fmaxf(mxB, fmaxf(sB[kb].x, sB[kb].y)), fmaxf(sB[kb].z, sB[kb].w)); }
                        mxA = xmax_16_32(mxA); mxB = xmax_16_32(mxB);
                    }
                    __builtin_amdgcn_sched_barrier(0);
                    u32x2 pA[18], pB[18];
#pragma unroll
                    for (int kb = 0; kb < 17; ++kb) {
                        f32x4 p; if (FAST) { p.x = __builtin_amdgcn_exp2f(sA[kb].x); p.y = __builtin_amdgcn_exp2f(sA[kb].y); p.z = __builtin_amdgcn_exp2f(sA[kb].z); p.w = __builtin_amdgcn_exp2f(sA[kb].w); } else { p.x = __builtin_amdgcn_exp2f(sA[kb].x - mxA); p.y = __builtin_amdgcn_exp2f(sA[kb].y - mxA); p.z = __builtin_amdgcn_exp2f(sA[kb].z - mxA); p.w = __builtin_amdgcn_exp2f(sA[kb].w - mxA); }
                        pA[kb] = cvtpk2(p);
                        f32x4 q; if (FAST) { q.x = __builtin_amdgcn_exp2f(sB[kb].x); q.y = __builtin_amdgcn_exp2f(sB[kb].y); q.z = __builtin_amdgcn_exp2f(sB[kb].z); q.w = __builtin_amdgcn_exp2f(sB[kb].w); } else { q.x = __builtin_amdgcn_exp2f(sB[kb].x - mxB); q.y = __builtin_amdgcn_exp2f(sB[kb].y - mxB); q.z = __builtin_amdgcn_exp2f(sB[kb].z - mxB); q.w = __builtin_amdgcn_exp2f(sB[kb].w - mxB); }
                        pB[kb] = cvtpk2(q);
                    }
                    pA[17] = (u32x2){0u, 0u}; pB[17] = (u32x2){0u, 0u};
                    __builtin_amdgcn_sched_barrier(0);
                    f32x4 lsA = (f32x4){0.f, 0.f, 0.f, 0.f}, lsB = (f32x4){0.f, 0.f, 0.f, 0.f};
                    f32x4 oA[4], oB[4];
#pragma unroll
                    for (int db = 0; db < 4; ++db) { oA[db] = (f32x4){0.f, 0.f, 0.f, 0.f}; oB[db] = (f32x4){0.f, 0.f, 0.f, 0.f}; }
#pragma unroll
                    for (int s2 = 0; s2 < 9; ++s2) {
                        u32x4 pa, pb; pa.x = pA[2 * s2].x; pa.y = pA[2 * s2].y; pa.z = pA[2 * s2 + 1].x; pa.w = pA[2 * s2 + 1].y; pb.x = pB[2 * s2].x; pb.y = pB[2 * s2].y; pb.z = pB[2 * s2 + 1].x; pb.w = pB[2 * s2 + 1].y;
                        const bf16x8_t pfA = __builtin_bit_cast(bf16x8_t, pa), pfB = __builtin_bit_cast(bf16x8_t, pb);
                        lsA = mfma16(ones8, pfA, lsA); lsB = mfma16(ones8, pfB, lsB);
#pragma unroll
                        for (int db = 0; db < 4; ++db) {
                            const LAS unsigned char* vp = L + AT_V + (16 * db + l15) * AT_VROW + (16 * w + 32 * s2 + 4 * h4) * 2;
                            const u32x2 lo = *(const LAS u32x2*)vp, hi = *(const LAS u32x2*)(vp + 32);
                            u32x4 vw; vw.x = lo.x; vw.y = lo.y; vw.z = hi.x; vw.w = hi.y;
                            const bf16x8_t vf = __builtin_bit_cast(bf16x8_t, vw);
                            oA[db] = mfma16(vf, pfA, oA[db]); oB[db] = mfma16(vf, pfB, oB[db]);
                        }
                    }
                    const float invA = __builtin_amdgcn_rcpf(lsA.x + __builtin_amdgcn_exp2f(skA - (FAST ? bref : mxA))), invB = __builtin_amdgcn_rcpf(lsB.x + __builtin_amdgcn_exp2f(skB - (FAST ? bref : mxB)));
                    {
                        LAS unsigned char* so = L + AT_O + w * (16 * AT_OROW);
#pragma unroll
                        for (int db = 0; db < 4; ++db) {
                            const f32x4 va = oA[db] * invA, vb = oB[db] * invB;
                            ssq += ((va.x * va.x + va.y * va.y) + (va.z * va.z + va.w * va.w)) + ((vb.x * vb.x + vb.y * vb.y) + (vb.z * vb.z + vb.w * vb.w));
                            u32x2 pk; pk.x = cvtpk(va.x, va.y); pk.y = cvtpk(va.z, va.w); *(LAS u32x2*)(so + l15 * AT_OROW + (16 * db + 4 * h4) * 2) = pk;
                            u32x2 pl; pl.x = cvtpk(vb.x, vb.y); pl.y = cvtpk(vb.z, vb.w); *(LAS u32x2*)(so + l15 * AT_OROW + (64 + 16 * db + 4 * h4) * 2) = pl;
                        }
                        asm volatile("s_waitcnt lgkmcnt(0)" ::: "memory");
#pragma unroll
                        for (int i = 0; i < 4; ++i) { const int row = 4 * i + h4; const u32x4 v = *(const LAS u32x4*)(so + row * AT_OROW + l15 * 16);
                            *(u32x4*)(MG + (size_t)(m0 + 16 * w + row) * D_MODEL + 64 * hA + 8 * l15) = v; }
                        asm volatile("s_waitcnt lgkmcnt(0)" ::: "memory");
                    }
                }
                };
                if (fast_ref) head_pairs(std::true_type{}); else head_pairs(std::false_type{});
                __syncthreads();
            }
            ssq = xsum_16_32(ssq);
            const int tl = lane_id(), tl15 = tl & 15;
            if ((tl >> 4) == 0) { const float ms = ssq * (1.0f / 512.0f) + EPS;
                *(LAS float*)(L + MX_RA + (16 * w + tl15) * 4) = ms * rsq_(ms);
                ((float*)(C.ws + WS_ARSTD))[m0 + 16 * w + tl15] = rsq_(ms); }
        }
        __syncthreads();
        {
            MIX_LANES();
            const bf16* GL = (const bf16*)(C.ws + WS_GLU);
            const float* cw = C.fin(I_CONV_W, (size_t)l * CONV_W * CONV_CH); const float* cb = C.fin(I_CONV_B, l * CONV_CH);
            const float* lg = C.fin(I_CONV_LN_G, l * CONV_CH); const float* lb = C.fin(I_CONV_LN_B, l * CONV_CH);
            const int c = tid & 255, q2 = tid >> 8;
            for (int i = tid; i < CONV_W * CONV_CH / 4; i += NWAVES * 64) *(LAS f32x4*)(L + CV_W + i * 16) = *((const f32x4*)cw + i);
            const float cbias = cb[c];
            f32x4 cg4[4], cb4[4];
#pragma unroll
            for (int k = 0; k < 4; ++k) { cg4[k] = *(const f32x4*)(lg + 4 * (lane & 15) + 64 * k); cb4[k] = *(const f32x4*)(lb + 4 * (lane & 15) + 64 * k); }
#pragma unroll 1
            for (int hp = 0; hp < 2; ++hp) {
                {
                    u32x4 sv[6];
#pragma unroll
                    for (int it = 0; it < 6; ++it) {
                        const int i = tid + it * (NWAVES * 64), ic = i < 94 * 32 ? i : 94 * 32 - 1, R = ic >> 5, ch = ic & 31, tp = tpos0 + 64 * hp - CONV_PAD + R;
                        const int tpc = tp < 0 ? 0 : (tp > SEQ - 1 ? SEQ - 1 : tp);
                        sv[it] = *(const u32x4*)(GL + (size_t)(m0 - tpos0 + tpc) * 256 + ch * 8);
                        if (tp != tpc) sv[it] = (u32x4){0u, 0u, 0u, 0u};
                    }
#pragma unroll
                    for (int it = 0; it < 6; ++it) { const int i = tid + it * (NWAVES * 64); if (i < 94 * 32) *(LAS u32x4*)(L + CV_G + (i >> 5) * CV_GROW + (i & 31) * 16) = sv[it]; }
                }
                __syncthreads();
                typedef float f32x2p __attribute__((ext_vector_type(2)));
                f32x2p w2[CONV_W + 1];
                {
                    float wk[CONV_W];
#pragma unroll
                    for (int k = 0; k < CONV_W; ++k) wk[k] = *(const LAS float*)(L + CV_W + k * (CONV_CH * 4) + c * 4);
#pragma unroll
                    for (int k = 0; k <= CONV_W; ++k) { w2[k].x = (k < CONV_W) ? wk[k] : 0.f; w2[k].y = (k > 0) ? wk[k - 1] : 0.f; }
                }
#pragma unroll 1
                for (int ob = 0; ob < 4; ++ob) {
                    f32x2p acc2[4];
#pragma unroll
                    for (int p2 = 0; p2 < 4; ++p2) acc2[p2] = (f32x2p){cbias, cbias};
                    const LAS unsigned short* gp = (const LAS unsigned short*)(L + CV_G + (32 * q2 + 8 * ob) * CV_GROW + c * 2);
                    unsigned short gx[38];
#pragma unroll
                    for (int j = 0; j < 38; ++j) gx[j] = gp[j * (CV_GROW / 2)];
                    __builtin_amdgcn_sched_barrier(0);
#pragma unroll
                    for (int j = 0; j < 38; ++j) {
                        const float x = __builtin_bit_cast(float, (unsigned)gx[j] << 16); const f32x2p x2 = (f32x2p){x, x};
#pragma unroll
                        for (int p2 = 0; p2 < 4; ++p2) { const int k = j - 2 * p2; if (k >= 0 && k <= CONV_W) acc2[p2] = __builtin_elementwise_fma(w2[k], x2, acc2[p2]); }
                    }
#pragma unroll
                    for (int p2 = 0; p2 < 4; ++p2) { *(LAS float*)(L + CV_Y + (32 * q2 + 8 * ob + 2 * p2) * CV_YROW + c * 4) = acc2[p2].x; *(LAS float*)(L + CV_Y + (32 * q2 + 8 * ob + 2 * p2 + 1) * CV_YROW + c * 4) = acc2[p2].y; }
                }
                __syncthreads();
                {
                    const int s16 = lane & 15, rsub = lane >> 4;
                    f32x4 v[2][4]; float t[2];
#pragma unroll
                    for (int bb = 0; bb < 2; ++bb)
#pragma unroll
                        for (int k = 0; k < 4; ++k) v[bb][k] = *(const LAS f32x4*)(L + CV_Y + (8 * w + 4 * bb + rsub) * CV_YROW + s16 * 16 + 256 * k);
#pragma unroll
                    for (int bb = 0; bb < 2; ++bb) { f32x4 a = (v[bb][0] + v[bb][1]) + (v[bb][2] + v[bb][3]); t[bb] = (a.x + a.y) + (a.z + a.w); }
#pragma unroll
                    for (int bb = 0; bb < 2; ++bb) t[bb] = rowsum16(t[bb]) * (1.0f / 256.0f);
#pragma unroll
                    for (int bb = 0; bb < 2; ++bb) { f32x4 q = (f32x4){0.f, 0.f, 0.f, 0.f};
#pragma unroll
                        for (int k = 0; k < 4; ++k) { v[bb][k] = v[bb][k] - t[bb]; q += v[bb][k] * v[bb][k]; }
                        t[bb] = (q.x + q.y) + (q.z + q.w); }
#pragma unroll
                    for (int bb = 0; bb < 2; ++bb) t[bb] = rsq_(rowsum16(t[bb]) * (1.0f / 256.0f) + EPS);
#pragma unroll
                    for (int bb = 0; bb < 2; ++bb) { f32x4 q = (f32x4){0.f, 0.f, 0.f, 0.f};
#pragma unroll
                        for (int k = 0; k < 4; ++k) { f32x4 y = v[bb][k] * t[bb] * cg4[k] + cb4[k];
                            y.x *= __builtin_amdgcn_rcpf(1.0f + __builtin_amdgcn_exp2f(-LOG2E * y.x)); y.y *= __builtin_amdgcn_rcpf(1.0f + __builtin_amdgcn_exp2f(-LOG2E * y.y));
                            y.z *= __builtin_amdgcn_rcpf(1.0f + __builtin_amdgcn_exp2f(-LOG2E * y.z)); y.w *= __builtin_amdgcn_rcpf(1.0f + __builtin_amdgcn_exp2f(-LOG2E * y.w));
                            v[bb][k] = y; q += y * y; }
                        t[bb] = (q.x + q.y) + (q.z + q.w); }
#pragma unroll
                    for (int bb = 0; bb < 2; ++bb) t[bb] = rsq_(rowsum16(t[bb]) * (1.0f / 256.0f) + EPS);
#pragma unroll
                    for (int bb = 0; bb < 2; ++bb)
#pragma unroll
                        for (int k = 0; k < 4; ++k) { const f32x4 y = v[bb][k] * (t[bb] * *(const LAS float*)(L + MX_RA + (64 * hp + 8 * w + 4 * bb + rsub) * 4)); u32x2 o; o.x = cvtpk(y.x, y.y); o.y = cvtpk(y.z, y.w);
                            *(u32x2*)(MG + (size_t)(m0 + 64 * hp + 8 * w + 4 * bb + rsub) * D_MODEL + 768 + 4 * s16 + 64 * k) = o; }
                }
                __syncthreads();
            }
        }
        {
            MIX_LANES();
            const bf16* VV = (const bf16*)(C.ws + WS_VV); const bf16* U = (const bf16*)(C.ws + WS_U);
            const float* lg = C.fin(I_GM_LN_G, l * GM_WIDTH); const float* lb = C.fin(I_GM_LN_B, l * GM_WIDTH);
            const bf16* Wb = (const bf16*)(C.ws + WS_WSBF) + (size_t)l * GM_HEADS * CHUNK * CHUNK; const float* bsp = C.fin(I_GM_BS, l * GM_HEADS * CHUNK);
            const int p = 16 * w + l15;
            bf16x8_t bw[4][4]; u32x2 uq[16]; float bsv[4];
#pragma unroll
            for (int h = 0; h < 4; ++h) {
#pragma unroll
                for (int s2 = 0; s2 < 4; ++s2) bw[h][s2] = *(const bf16x8_t*)(Wb + ((size_t)(h * CHUNK + p)) * CHUNK + 32 * s2 + 8 * h4);
                bsv[h] = bsp[h * CHUNK + p];
            }
            {
                const int s16 = lane & 15, rsub = lane >> 4;
                u32x4 xv[4][2]; float t[4], mu[4];
#pragma unroll
                for (int bb = 0; bb < 4; ++bb)
#pragma unroll
                    for (int k = 0; k < 2; ++k) xv[bb][k] = *(const u32x4*)(VV + (size_t)(m0 + 16 * w + 4 * bb + rsub) * 256 + 16 * s16 + 8 * k);
#pragma unroll
                for (int bb = 0; bb < 4; ++bb) { float a = 0.f;
#pragma unroll
                    for (int k = 0; k < 2; ++k) a += ((bflo(xv[bb][k].x) + bfhi(xv[bb][k].x)) + (bflo(xv[bb][k].y) + bfhi(xv[bb][k].y))) + ((bflo(xv[bb][k].z) + bfhi(xv[bb][k].z)) + (bflo(xv[bb][k].w) + bfhi(xv[bb][k].w)));
                    t[bb] = a; }
#pragma unroll
                for (int bb = 0; bb < 4; ++bb) mu[bb] = rowsum16(t[bb]) * (1.0f / 256.0f);
#pragma unroll
                for (int bb = 0; bb < 4; ++bb) { float a = 0.f; const float m_ = mu[bb];
#pragma unroll
                    for (int k = 0; k < 2; ++k) { const u32x4 x = xv[bb][k];
                        const float d0 = bflo(x.x) - m_, d1 = bfhi(x.x) - m_, d2 = bflo(x.y) - m_, d3 = bfhi(x.y) - m_, d4 = bflo(x.z) - m_, d5 = bfhi(x.z) - m_, d6 = bflo(x.w) - m_, d7 = bfhi(x.w) - m_;
                        a += ((d0 * d0 + d1 * d1) + (d2 * d2 + d3 * d3)) + ((d4 * d4 + d5 * d5) + (d6 * d6 + d7 * d7)); }
                    t[bb] = a; }
#pragma unroll
                for (int bb = 0; bb < 4; ++bb) { const float var = rowsum16(t[bb]) * (1.0f / 256.0f);
                    if (s16 == 0) { const int q = 16 * w + 4 * bb + rsub; *(LAS float*)(L + GM_ST + q * 8) = mu[bb]; *(LAS float*)(L + GM_ST + q * 8 + 4) = rsq_(var + EPS); } }
            }
            __syncthreads();
            {
                const int q = tid & 127, dblk = tid >> 7;
                const float mean = *(const LAS float*)(L + GM_ST + q * 8), rstd = *(const LAS float*)(L + GM_ST + q * 8 + 4);
#pragma unroll
                for (int j = 0; j < 8; ++j) {
                    const int d0 = dblk * 64 + 8 * j;
                    const u32x4 x = *(const u32x4*)(VV + (size_t)(m0 + q) * 256 + d0);
                    const f32x4 ga = *(const f32x4*)(lg + d0), gb = *(const f32x4*)(lg + d0 + 4), ba = *(const f32x4*)(lb + d0), bb = *(const f32x4*)(lb + d0 + 4);
                    const float v[8] = {bflo(x.x), bfhi(x.x), bflo(x.y), bfhi(x.y), bflo(x.z), bfhi(x.z), bflo(x.w), bfhi(x.w)};
                    const float gg[8] = {ga.x, ga.y, ga.z, ga.w, gb.x, gb.y, gb.z, gb.w}, bbv[8] = {ba.x, ba.y, ba.z, ba.w, bb.x, bb.y, bb.z, bb.w};
#pragma unroll
                    for (int e = 0; e < 8; ++e) *(LAS unsigned short*)(L + GM_T + (d0 + e) * GM_TROW + q * 2) = (unsigned short)f2bf((v[e] - mean) * rstd * gg[e] + bbv[e]);
                }
            }
            __syncthreads();
            {
#pragma unroll
                for (int db = 0; db < 16; ++db) uq[db] = *(const u32x2*)(U + (size_t)(m0 + p) * 256 + 16 * db + 4 * h4);
                f32x4 acc[16];
                bf16x8_t af[2][2][4];
#define GM_RD(hb_) do { _Pragma("unroll") for (int dbl = 0; dbl < 2; ++dbl) _Pragma("unroll") for (int s2 = 0; s2 < 4; ++s2) \
        af[(hb_) & 1][dbl][s2] = *(const LAS bf16x8_t*)(L + GM_T + (16 * (2 * (hb_) + dbl) + l15) * GM_TROW + 64 * s2 + 16 * h4); } while (0)
                GM_RD(0);
#pragma unroll
                for (int hb = 0; hb < 8; ++hb) {
                    __builtin_amdgcn_sched_barrier(0);
                    if (hb + 1 < 8) GM_RD(hb + 1);
                    __builtin_amdgcn_sched_barrier(0);
                    f32x4 a0 = (f32x4){0.f, 0.f, 0.f, 0.f}, a1 = (f32x4){0.f, 0.f, 0.f, 0.f};
#pragma unroll
                    for (int s2 = 0; s2 < 4; ++s2) { a0 = mfma16(af[hb & 1][0][s2], bw[hb >> 1][s2], a0); a1 = mfma16(af[hb & 1][1][s2], bw[hb >> 1][s2], a1); }
                    acc[2 * hb] = a0; acc[2 * hb + 1] = a1;
                }
                __builtin_amdgcn_sched_barrier(0);
#undef GM_RD
                float ss = 0.f;
#pragma unroll
                for (int db = 0; db < 16; ++db) {
                    const float bias = bsv[db >> 2];
                    const u32x2 uu = uq[db];
                    f32x4 o; o.x = bflo(uu.x) * (acc[db].x + bias); o.y = bfhi(uu.x) * (acc[db].y + bias); o.z = bflo(uu.y) * (acc[db].z + bias); o.w = bfhi(uu.y) * (acc[db].w + bias);
                    acc[db] = o; ss += (o.x * o.x + o.y * o.y) + (o.z * o.z + o.w * o.w);
                }
                ss = xsum_16_32(ss);
                const float r = rsq_(ss * (1.0f / 256.0f) + EPS) * *(const LAS float*)(L + MX_RA + p * 4);
#pragma unroll
                for (int db = 0; db < 16; ++db) { u32x2 o; o.x = cvtpk(acc[db].x * r, acc[db].y * r); o.y = cvtpk(acc[db].z * r, acc[db].w * r);
                    *(u32x2*)(MG + (size_t)(m0 + p) * D_MODEL + 512 + 16 * db + 4 * h4) = o; }
            }
            __syncthreads();
        }
        __syncthreads();
    }
}

constexpr int STEPS_PER_LAYER = 6, N_STEPS = 1 + DEPTH * STEPS_PER_LAYER;

template <int S>
__device__ __forceinline__ void run_step(const Ctx& C) {
    float* partA = (float*)(C.ws + WS_PARTA); float* partB = (float*)(C.ws + WS_PARTB);
    if constexpr (S == 0) { step_prologue(C); step_wprep(C); }
    else {
        constexpr int l = (S - 1) / STEPS_PER_LAYER, k = (S - 1) % STEPS_PER_LAYER;
        float* pin = (l & 1) ? partB : partA; float* pot = (l & 1) ? partA : partB;
        bf16* XB = (bf16*)(C.ws + WS_XBF); bf16* XB2 = (bf16*)(C.ws + WS_XBF2);
        if constexpr (k == 0) { for (int rip_ = 0; rip_ < REP_IP; ++rip_) { step_inproj_opt(C, l, pin); if (rip_ + 1 < REP_IP) __syncthreads(); } }
        else if constexpr (k == 1) step_mixer_opt(C, l);
        else if constexpr (k == 2) step_resid_opt<0, false, true>(C, (const bf16*)(C.ws + WS_MERGED), D_MODEL, wcopy(C, l, WO_OUT), l == 0 ? XB : XB2, XB, nullptr, pot);
        else if constexpr (k == 3) { for (int rgu_ = 0; rgu_ < REP_GU; ++rgu_) { step_gateup_opt(C, l, pot); if (rgu_ + 1 < REP_GU) __syncthreads(); } }
        else if constexpr (k == 4) step_resid_opt<0, false, false, true>(C, (const bf16*)(C.ws + WS_ACT), ACT_ROW_BYTES / 2, wcopy(C, l, WO_DOWN), XB, XB, nullptr, pin);
        else { const bf16* X8A = (const bf16*)(C.ws + WS_X8);
               if constexpr (l == DEPTH - 1) step_resid_opt<1, true, false, true>(C, X8A, D_MODEL / 2, wcopy(C, l, WO_PG), XB, XB2, pin, pot);
               else step_resid_opt<1, false, false, true>(C, X8A, D_MODEL / 2, wcopy(C, l, WO_PG), XB, XB2, pin, pot); }
    }
}
__device__ __forceinline__ Ctx make_ctx(const Args& args, int wave, LAS unsigned char* lds) {
    Ctx C; C.a = &args; C.ws = args.ws; C.out = args.out; C.lds = lds;
    C.lane = lane_id(); C.wave = wave; C.tid = wave * 64 + C.lane;
    C.gw = blockIdx.x * NWAVES + wave; C.ngw = gridDim.x * NWAVES; C.gtid = blockIdx.x * (NWAVES * 64) + C.tid; C.ngt = gridDim.x * NWAVES * 64;
    return C;
}
template <int S>
__device__ __forceinline__ void run_steps(const Args& args, int wave, LAS unsigned char* lds, const XcdBarrier& bar, int lo, int hi) {
    if constexpr (S < N_STEPS) {
        if (lo <= S && S < hi) {
            if (S == REPEAT_STEP) { { const Ctx C = make_ctx(args, wave, lds); run_step<S>(C); } xcd_barrier(bar, wave == 0 && lane_id() == 0); }
            { const Ctx C = make_ctx(args, wave, lds); run_step<S>(C); } if (S + 1 < hi) xcd_barrier(bar, wave == 0 && lane_id() == 0); }
        run_steps<S + 1>(args, wave, lds, bar, lo, hi);
    }
}

__global__ void __launch_bounds__(NWAVES * 64) __attribute__((amdgpu_waves_per_eu(2, 2))) mega(Args args) {
    extern __shared__ __attribute__((aligned(16))) unsigned char lds_raw[];
    LAS unsigned char* lds = (LAS unsigned char*)lds_raw;
    const int wave = __builtin_amdgcn_readfirstlane(threadIdx.x >> 6);
    volatile LAS unsigned* MISC = (volatile LAS unsigned*)(lds + MISC_OFF);
    for (int u = threadIdx.x; u < (LDS_BYTES - LDSCTL_OFF) / 4; u += NWAVES * 64) ((LAS unsigned*)(lds + LDSCTL_OFF))[u] = 0u;
    __syncthreads();
    unsigned* ctl = (unsigned*)(args.ws + WS_CTL);
    XcdBarrier bar; bar.bar = ctl + CW_BAR; bar.x = 0; bar.st = nullptr;
    const bool multi = (args.st_hi - args.st_lo) > 1;
    if (multi) bar = xcd_barrier_post(ctl + CW_BAR + args.li * XCD_BAR_WORDS, MISC + 8, wave == 0 && lane_id() == 0);
    run_steps<0>(args, wave, lds, bar, args.st_lo, args.st_hi);
}

extern "C" void kernel_launch(void* const* d_in, const int* in_sizes, int n_in, void* d_out, int out_size, void* d_ws, size_t ws_size, hipStream_t stream) {
    static int grid = 0;
    if (grid == 0) {
        if (n_in != N_IN || in_sizes[0] != M * D_MODEL || out_size != M * D_MODEL || ws_size < WS_END) {
            fprintf(stderr, "kernel_launch: shape/workspace mismatch (n_in %d, in0 %d, out %d, ws %zu, need %zu); nothing launched\n", n_in, n_in > 0 ? in_sizes[0] : -1, out_size, ws_size, (size_t)WS_END); grid = -1; return; }
        int dev = 0, cus = 0, per_cu = 0;
        if (hipGetDevice(&dev) != hipSuccess || hipDeviceGetAttribute(&cus, hipDeviceAttributeMultiprocessorCount, dev) != hipSuccess) { grid = -1; return; }
        if (hipFuncSetAttribute((const void*)mega, hipFuncAttributeMaxDynamicSharedMemorySize, LDS_BYTES) != hipSuccess) { fprintf(stderr, "kernel_launch: hipFuncSetAttribute failed\n"); grid = -1; return; }
        if (hipOccupancyMaxActiveBlocksPerMultiprocessor(&per_cu, (const void*)mega, NWAVES * 64, LDS_BYTES) != hipSuccess || per_cu < 1) { fprintf(stderr, "kernel_launch: occupancy query says %d blocks per CU; nothing launched\n", per_cu); (void)hipGetLastError(); grid = -1; return; }
        grid = cus;
    }
    if (grid < 0) return;
    if (hipMemsetAsync((char*)d_ws + WS_CTL, 0, CTL_ZERO_BYTES, stream) != hipSuccess) return;
    Args a{};
    for (int i = 0; i < N_IN; ++i) a.in[i] = d_in[i];
    a.out = (float*)d_out; a.ws = (unsigned char*)d_ws;
    if (MK_N_LAUNCHES == 1) {
        a.st_lo = 0; a.st_hi = N_STEPS; a.li = 0;
        hipLaunchKernelGGL(mega, dim3(grid), dim3(NWAVES * 64), LDS_BYTES, stream, a);
    } else {
        for (int s = 0; s < N_STEPS; ++s) { a.st_lo = s; a.st_hi = s + 1; a.li = 0; hipLaunchKernelGGL(mega, dim3(grid), dim3(NWAVES * 64), LDS_BYTES, stream, a); }
    }
}
```

```cpp
#include <hip/hip_runtime.h>
#include <cstdio>
#include <cstdint>
#include <type_traits>

#ifndef REP_GU
#define REP_GU 1
#endif
#ifndef REP_IP
#define REP_IP 1
#endif
#ifndef REP_MIX
#define REP_MIX 1
#endif
#ifndef REPEAT_STEP
#define REPEAT_STEP -1
#endif
#ifndef ATT_STAGGER
#define ATT_STAGGER 40
#endif
#ifndef MK_N_LAUNCHES
#define MK_N_LAUNCHES 1
#endif

constexpr int D_MODEL = 1024, BATCH = 8, SEQ = 4096, DEPTH = 2, M = BATCH * SEQ;
constexpr int HEAD_DIM = 64, ATTN_WIDTH = 512, NQH = 8, NKVH = 2, KV_WIDTH = 128, WINDOW = 128;
constexpr int GM_WIDTH = 256, GM_HEADS = 4, CHUNK = 128, CONV_CH = 256, CONV_W = 31, CONV_PAD = 15, D_FF = 2816, PLE_DIM = 256;
constexpr int Q_OFF = 0, K_OFF = 512, V_OFF = 640, GM_OFF = 768, CONV_OFF = 1280, IN_COLS = 1792;
constexpr float EPS = 1e-6f;
constexpr int DOWN_K8 = 2048;
constexpr int ACT_ROW_BYTES = DOWN_K8 + 2 * (D_FF - DOWN_K8);
static_assert(DOWN_K8 % 256 == 0 && ACT_ROW_BYTES % 256 == 0, "whole pairs of 128-byte K-tiles on both sides of the split");
constexpr int RB = 8;
constexpr float LOG2E = 1.4426950408889634f;
constexpr float C2 = 0.125f * 1.4426950408889634f;

enum { I_X = 0, I_P, I_POS, I_NORM_MIX_G, I_W_IN, I_QG, I_KG, I_SINK, I_GM_LN_G, I_GM_LN_B, I_GM_WS, I_GM_BS, I_CONV_W, I_CONV_B, I_CONV_LN_G, I_CONV_LN_B,
       I_OUT_NORM_G, I_W_OUT, I_NORM_FFN_G, I_W_GU, I_W_DOWN, I_PLE_NORM_G, I_W_PG, I_W_PP, N_IN };

constexpr size_t MiB = 1u << 20;
constexpr size_t WS_CTL = 0, CTL_ZERO_BYTES = 1 * MiB;
constexpr size_t WS_COS = 1 * MiB, WS_SIN = 2 * MiB;
constexpr size_t WS_PARTA = 3 * MiB, WS_PARTB = 5 * MiB;
constexpr size_t WS_VSTAT = 7 * MiB;
constexpr size_t WS_ARSTD = 7 * MiB;
constexpr size_t WS_WSBF = 7 * MiB + 512 * 1024;
constexpr size_t WS_W = 8 * MiB, W_LAYER = 24 * MiB + 512 * 1024;
constexpr size_t WO_IN = 0, WO_OUT = 3 * MiB + 512 * 1024, WO_GU = 5 * MiB + 512 * 1024, WO_DOWN = 16 * MiB + 512 * 1024, WO_PG = 22 * MiB, WO_PP = 24 * MiB;
static_assert(WS_W + 2 * W_LAYER <= 64 * MiB, "weight copies end below xbf");
constexpr size_t WS_XBF = 64 * MiB;
constexpr size_t WS_PJ = 128 * MiB;
constexpr size_t WS_PBF = 192 * MiB;
constexpr size_t WS_R1 = 224 * MiB;
constexpr size_t WS_Q = WS_R1, WS_K = WS_R1 + 32 * MiB, WS_V = WS_R1 + 40 * MiB, WS_U = WS_R1 + 48 * MiB, WS_VV = WS_R1 + 64 * MiB, WS_GLU = WS_R1 + 80 * MiB;
constexpr size_t WS_MERGED = WS_R1 + 112 * MiB;
static_assert((size_t)M * ACT_ROW_BYTES <= 112 * MiB, "act overlays q..glu only");
constexpr size_t WS_XBF2 = 400 * MiB;
constexpr size_t WS_ACT = WS_R1;
constexpr size_t WS_X8 = 464 * MiB;
constexpr size_t WS_END = 496 * MiB;

typedef unsigned short bf16;
typedef float f32x4 __attribute__((ext_vector_type(4)));
typedef unsigned u32x4 __attribute__((ext_vector_type(4)));
typedef unsigned u32x2 __attribute__((ext_vector_type(2)));
#define LAS __attribute__((address_space(3)))
#define GAS __attribute__((address_space(1)))
typedef GAS unsigned gu32;
#define RLX_AGENT __ATOMIC_RELAXED, __HIP_MEMORY_SCOPE_AGENT

__device__ __forceinline__ unsigned f2bf(float f) { unsigned u = __builtin_bit_cast(unsigned, f); return (u + 0x7fffu + ((u >> 16) & 1u)) >> 16; }
__device__ __forceinline__ unsigned pk2(float lo, float hi) { return f2bf(lo) | (f2bf(hi) << 16); }
__device__ __forceinline__ float bflo(unsigned u) { return __builtin_bit_cast(float, u << 16); }
__device__ __forceinline__ float bfhi(unsigned u) { return __builtin_bit_cast(float, u & 0xffff0000u); }
__device__ __forceinline__ float bf2f(bf16 b) { return __builtin_bit_cast(float, (unsigned)b << 16); }
#define dpp_(x, ctrl, row_mask, bc) __builtin_bit_cast(float, __builtin_amdgcn_update_dpp(0, __builtin_bit_cast(int, (x)), (ctrl), (row_mask), 0xf, (bc)))
__device__ __forceinline__ float wave_sum(float v) {
    v += dpp_(v, 0xB1, 0xf, true); v += dpp_(v, 0x4E, 0xf, true); v += dpp_(v, 0x141, 0xf, true); v += dpp_(v, 0x140, 0xf, true);
    v += dpp_(v, 0x142, 0xa, false); v += dpp_(v, 0x143, 0xc, false);
    return __builtin_bit_cast(float, __builtin_amdgcn_readlane(__builtin_bit_cast(int, v), 63));
}
__device__ __forceinline__ float rowsum16(float v) { v += dpp_(v, 0xB1, 0xf, true); v += dpp_(v, 0x4E, 0xf, true); v += dpp_(v, 0x141, 0xf, true); v += dpp_(v, 0x140, 0xf, true); return v; }
__device__ __forceinline__ float xsum_16_32(float v) {
    const unsigned a = __builtin_bit_cast(unsigned, v); const auto r = __builtin_amdgcn_permlane16_swap(a, a, false, false);
    v = __builtin_bit_cast(float, (unsigned)r[0]) + __builtin_bit_cast(float, (unsigned)r[1]);
    const unsigned b = __builtin_bit_cast(unsigned, v); const auto q = __builtin_amdgcn_permlane32_swap(b, b, false, false);
    return __builtin_bit_cast(float, (unsigned)q[0]) + __builtin_bit_cast(float, (unsigned)q[1]);
}
__device__ __forceinline__ float xmax_16_32(float v) {
    const unsigned a = __builtin_bit_cast(unsigned, v); const auto r = __builtin_amdgcn_permlane16_swap(a, a, false, false);
    v = fmaxf(__builtin_bit_cast(float, (unsigned)r[0]), __builtin_bit_cast(float, (unsigned)r[1]));
    const unsigned b = __builtin_bit_cast(unsigned, v); const auto q = __builtin_amdgcn_permlane32_swap(b, b, false, false);
    return fmaxf(__builtin_bit_cast(float, (unsigned)q[0]), __builtin_bit_cast(float, (unsigned)q[1]));
}
__device__ __forceinline__ int lane_id() { int l; asm volatile("v_mbcnt_lo_u32_b32 %0, -1, 0\n\tv_mbcnt_hi_u32_b32 %0, -1, %0" : "=v"(l)); return l; }
__host__ __device__ __forceinline__ size_t tiled_off(int row, int bytecol, int rowbytes) { return ((size_t)((row >> 4) * (rowbytes >> 6) + (bytecol >> 6)) << 10) + (size_t)(((row & 15) << 6) + (bytecol & 63)); }
__device__ __forceinline__ float sigmoidf_(float x) { return 1.0f / (1.0f + __expf(-x)); }

#define XB_TMO      128
#define XB_XCNT(j)  (256  + 64 * (j))
#define XB_XSUB(j)  (1280 + 64 * (j))
#define XB_XGEN(j)  (2304 + 64 * (j))
#define XB_TOP      3328
#define XB_TOPGEN   3392
#define XCD_BAR_WORDS 3456
#define XB_SPIN_CAP (1u << 22)
constexpr int CW_BAR = 4096;

__device__ __forceinline__ unsigned xb_ld(unsigned* p)              { return __hip_atomic_load(p, __ATOMIC_RELAXED, __HIP_MEMORY_SCOPE_AGENT); }
__device__ __forceinline__ unsigned xb_add(unsigned* p, unsigned v) { return __hip_atomic_fetch_add(p, v, __ATOMIC_RELAXED, __HIP_MEMORY_SCOPE_AGENT); }
__device__ __forceinline__ unsigned xb_xcc_id() { return (unsigned)__builtin_amdgcn_s_getreg((3 << 11) | 20) & 0xFu; }
#define XB_SPIN(cond, bar) do { unsigned _sp = 0; while (cond) { __builtin_amdgcn_s_sleep(1); \
    if ((++_sp & 255u) == 0u) { if (xb_ld(&(bar)[XB_TMO])) break; if (_sp > XB_SPIN_CAP) { atomicAdd(&(bar)[XB_TMO], 1u); break; } } } } while (0)

struct XcdBarrier { unsigned* bar; unsigned x; volatile LAS unsigned* st; };
__device__ __forceinline__ XcdBarrier xcd_barrier_post(unsigned* bar, volatile LAS unsigned* st, bool leader) {
    XcdBarrier b; b.bar = bar; b.x = xb_xcc_id(); b.st = st;
    if (leader) (void)xb_add(&bar[XB_XCNT(b.x)], 1u);
    return b;
}
__device__ __forceinline__ void xcd_barrier_complete(unsigned* bar, unsigned x, unsigned& nloc, unsigned& nx) {
    const unsigned G = gridDim.x * gridDim.y * gridDim.z;
    unsigned sum, cnt, mine, sp = 0u;
    for (;;) {
        sum = 0u; cnt = 0u; mine = 0u;
#pragma unroll
        for (unsigned j = 0; j < 16; ++j) { const unsigned c = xb_ld(&bar[XB_XCNT(j)]); sum += c; cnt += (c > 0u) ? 1u : 0u; mine = (j == x) ? c : mine; }
        if (sum == G) break;
        __builtin_amdgcn_s_sleep(1);
        if ((++sp & 255u) == 0u) { if (xb_ld(&bar[XB_TMO])) break; if (sp > XB_SPIN_CAP) { atomicAdd(&bar[XB_TMO], 1u); break; } }
    }
    nloc = mine > 0u ? mine : 1u; nx = cnt > 0u ? cnt : 1u;
}
__device__ __forceinline__ void xcd_barrier(const XcdBarrier& b, bool leader) {
    asm volatile("s_waitcnt vmcnt(0)" ::: "memory");
    __syncthreads();
    if (leader) {
        unsigned* bar = b.bar;
        __builtin_amdgcn_s_waitcnt(0);
        unsigned nloc = b.st[0], nx = b.st[1];
        if (nloc == 0u) { xcd_barrier_complete(bar, b.x, nloc, nx); b.st[0] = nloc; b.st[1] = nx; }
        const unsigned old = xb_add(&bar[XB_XSUB(b.x)], 1u);
        const unsigned gen = old / nloc;
        if (old + 1u == (gen + 1u) * nloc) {
            __builtin_amdgcn_fence(__ATOMIC_RELEASE, "agent");
            asm volatile("s_waitcnt vmcnt(0)" ::: "memory");
            (void)xb_add(&bar[XB_TOP], 1u);
        }
        XB_SPIN(xb_ld(&bar[XB_TOP]) < (gen + 1u) * nx, bar);
        __builtin_amdgcn_fence(__ATOMIC_ACQUIRE, "agent");
        asm volatile("s_waitcnt vmcnt(0)" ::: "memory");
    }
    __syncthreads();
}

constexpr int CW_XID = 16384, CW_QB = 20480;
constexpr int CW_MDONE = 28672;
__device__ __forceinline__ void quad_barrier(unsigned* ctl, volatile LAS unsigned* qs, unsigned xcc, unsigned k  , bool leader, bool count_mixer = false, int nb_qid = -1  ) {
    asm volatile("s_waitcnt vmcnt(0)" ::: "memory");
    __syncthreads();
    if (leader) {
        __builtin_amdgcn_s_waitcnt(0);
        if (count_mixer) (void)xb_add(ctl + CW_MDONE, 1u);
        const unsigned c = blockIdx.x, g = c & 7u, q = (c >> 3) & 7u;
        unsigned nloc = qs[0], nx = qs[1];
        if (nloc == 0u) {
            const unsigned i0 = xb_ld(ctl + CW_XID + g + 8u * q), i1 = xb_ld(ctl + CW_XID + g + 8u * (q + 8u)), i2 = xb_ld(ctl + CW_XID + g + 8u * (q + 16u)), i3 = xb_ld(ctl + CW_XID + g + 8u * (q + 24u));
            const unsigned me = xcc + 1u;
            nloc = (i0 == me ? 1u : 0u) + (i1 == me ? 1u : 0u) + (i2 == me ? 1u : 0u) + (i3 == me ? 1u : 0u);
            nx = 1u + (i1 != i0 ? 1u : 0u) + ((i2 != i0 && i2 != i1) ? 1u : 0u) + ((i3 != i0 && i3 != i1 && i3 != i2) ? 1u : 0u);
            qs[0] = nloc; qs[1] = nx;
        }
        unsigned* qb = ctl + CW_QB + (g * 8u + q) * 64u;
        const unsigned old = xb_add(&qb[xcc], 1u);
        if (old + 1u == (k + 1u) * nloc) {
            __builtin_amdgcn_fence(__ATOMIC_RELEASE, "agent");
            asm volatile("s_waitcnt vmcnt(0)" ::: "memory");
            (void)xb_add(&qb[32], 1u);
        }
        XB_SPIN(xb_ld(&qb[32]) < (k + 1u) * nx, ctl + CW_BAR);
        __hip_atomic_store(&qb[33], k + 1u, __ATOMIC_RELAXED, __HIP_MEMORY_SCOPE_AGENT);
        if (nb_qid >= 0) { unsigned* nb = ctl + CW_QB + (unsigned)nb_qid * 64u; XB_SPIN(xb_ld(&nb[33]) < k + 1u, ctl + CW_BAR); }
        __builtin_amdgcn_fence(__ATOMIC_ACQUIRE, "agent");
        asm volatile("s_waitcnt vmcnt(0)" ::: "memory");
    }
    __syncthreads();
}

__device__ __forceinline__ void mixer_done_wait(unsigned* ctl, unsigned target, bool leader) {
    if (leader) { XB_SPIN(xb_ld(ctl + CW_MDONE) < target, ctl + CW_BAR); }
    __syncthreads();
}

namespace pg8 {
#define PG8_LAS __attribute__((address_space(3)))
typedef unsigned short bf16_t;
typedef short bf16x8 __attribute__((ext_vector_type(8)));
typedef float f32x4 __attribute__((ext_vector_type(4)));
typedef unsigned u32x4 __attribute__((ext_vector_type(4)));
constexpr int BM = 256, BK = 64, HALF = 128, HTB = HALF * BK * 2  , STAGE_BYTES = 8 * HTB, NXCD = 8, WGM = 8;

__host__ __device__ __forceinline__ int lds_byte(int r, int c) { const int st = (r >> 4) * 2 + (c >> 5), rr = r & 15, cc = c & 31, ob = rr * 64 + cc * 2; return st * 1024 + (ob ^ (((ob >> 9) & 1) << 5)); }
__host__ __device__ __forceinline__ void stage_rc(int b, int& R, int& C) { const int st = b / 1024, sb = b % 1024, swz = sb ^ (((sb >> 9) & 1) << 5); R = (st >> 1) * 16 + swz / 64; C = (st & 1) * 32 + (swz % 64) / 2; }
__host__ __device__ __forceinline__ int perm32(int rho) { const int n = rho >> 4, i = rho & 15; return 8 * (i >> 2) + 4 * n + (i & 3); }

struct Unit { int pm, pn; };
struct Gemm { const bf16_t* A; const bf16_t* Bt; int M, N, K; int nt8 = 0; };

struct StaticOrder {
    int nM, nN, nwg, G, c;
    __host__ __device__ void init(int M, int N, int G_, int c_) { nM = M / BM; nN = N / BM; nwg = nM * nN; G = G_; c = c_; }
    __host__ __device__ bool next(int i, Unit& u) const {
        const long L = (long)i * G + c; if (L >= nwg) return false;
        int wgid = (int)L; { const int q = nwg / NXCD, r = nwg % NXCD, xcd = wgid % NXCD, off = wgid / NXCD; wgid = (xcd < r ? xcd * (q + 1) : r * (q + 1) + (xcd - r) * q) + off; }
        const int nig = WGM * nN, gid = wgid / nig, fm = gid * WGM, gsz = (nM - fm) < WGM ? (nM - fm) : WGM;
        u.pm = fm + ((wgid % nig) % gsz); u.pn = (wgid % nig) / gsz; return true;
    }
    __device__ __forceinline__ void a_ready(const Unit&) const {}
    __device__ __forceinline__ void done(const Unit&) const {}
};

__device__ __forceinline__ unsigned cvt_pk_bf16(float lo, float hi) { unsigned r; asm volatile("v_cvt_pk_bf16_f32 %0, %1, %2" : "=v"(r) : "v"(lo), "v"(hi)); return r; }
typedef int i32x4 __attribute__((ext_vector_type(4)));
typedef int i32x8 __attribute__((ext_vector_type(8)));
typedef unsigned u32x2_ __attribute__((ext_vector_type(2)));
constexpr float W8_SCALE = 128.0f;
__device__ __forceinline__ u32x2_ pack8_fp8(const f32x4 a, const f32x4 b) {
    int lo = 0, hi = 0; lo = __builtin_amdgcn_cvt_pk_fp8_f32(a[0], a[1], lo, false); lo = __builtin_amdgcn_cvt_pk_fp8_f32(a[2], a[3], lo, true);
    hi = __builtin_amdgcn_cvt_pk_fp8_f32(b[0], b[1], hi, false); hi = __builtin_amdgcn_cvt_pk_fp8_f32(b[2], b[3], hi, true); return (u32x2_){(unsigned)lo, (unsigned)hi}; }
__device__ __forceinline__ void mfma_f8_acc(f32x4& c, const i32x8 a, const i32x8 b) { asm volatile("v_mfma_f32_16x16x128_f8f6f4 %0, %1, %2, %0" : "+v"(c) : "v"(a), "v"(b)); }
__device__ __forceinline__ i32x8 cat8(const bf16x8 a, const bf16x8 b) { return __builtin_shufflevector(__builtin_bit_cast(i32x4, a), __builtin_bit_cast(i32x4, b), 0, 1, 2, 3, 4, 5, 6, 7); }
__device__ __forceinline__ u32x4 pack8(const f32x4 a, const f32x4 b) { u32x4 w; w.x = cvt_pk_bf16(a[0], a[1]); w.y = cvt_pk_bf16(a[2], a[3]); w.z = cvt_pk_bf16(b[0], b[1]); w.w = cvt_pk_bf16(b[2], b[3]); return w; }
typedef float f32x2 __attribute__((ext_vector_type(2)));
__device__ __forceinline__ f32x2 gelu_pk(f32x2 v) {
    const f32x2 av = __builtin_elementwise_abs(v), d = av * 0.2316418882f + 1.0f;
    f32x2 t; t.x = __builtin_amdgcn_rcpf(d.x); t.y = __builtin_amdgcn_rcpf(d.y);
    f32x2 q = t * 0.5307027145f + (-0.7265760135f); q = q * t + 0.7107068705f; q = q * t + (-0.142248368f); q = q * t + 0.127414796f; q = q * t;
    const f32x2 s = (v * v) * (-0.72134752044f);
    f32x2 e; e.x = __builtin_amdgcn_exp2f(s.x); e.y = __builtin_amdgcn_exp2f(s.y);
    const f32x2 m = v * (q * e), r = v - m;
    f32x2 o; o.x = v.x < 0.f ? m.x : r.x; o.y = v.y < 0.f ? m.y : r.y; return o;
}
__device__ __forceinline__ f32x4 gelu4(const f32x4 v) { const f32x2 a = gelu_pk((f32x2){v[0], v[1]}), b = gelu_pk((f32x2){v[2], v[3]}); return (f32x4){a.x, a.y, b.x, b.y}; }
__device__ __forceinline__ float sigm(float x) { return __builtin_amdgcn_rcpf(1.0f + __builtin_amdgcn_exp2f(x * -1.4426950408889634f)); }
__device__ __forceinline__ f32x4 sigm4(const f32x4 v) { return (f32x4){sigm(v[0]), sigm(v[1]), sigm(v[2]), sigm(v[3])}; }
__device__ __forceinline__ float dot4(const f32x4 a) { return (a[0] * a[0] + a[1] * a[1]) + (a[2] * a[2] + a[3] * a[3]); }
constexpr int RT_OFF = 131072, RT_SLOTS = 4;
struct RstdTab { int pm0, pm1, pm2, pm3; PG8_LAS unsigned char* lds; };
__device__ __forceinline__ void epi_rstd(const RstdTab& T, int pm, int rloc  , float (&rs)[2][4]) {
    const int slot = (pm == T.pm0) ? 0 : (pm == T.pm1) ? 1 : (pm == T.pm2) ? 2 : 3;
    const PG8_LAS float* tp = (const PG8_LAS float*)(T.lds + RT_OFF + slot * 1024) + rloc;
#pragma unroll
    for (int ai = 0; ai < 2; ++ai)
#pragma unroll
        for (int m = 0; m < 4; ++m) rs[ai][m] = tp[ai * HALF + m * 16];
}
struct TabJob { const float* src; int mode; };
template <class Sched>
__device__ __forceinline__ RstdTab table_slots(PG8_LAS unsigned char* lds, const Sched& S) {
    RstdTab T; T.pm0 = T.pm1 = T.pm2 = T.pm3 = -1; T.lds = lds;
    Unit u;
    for (int i = 0; S.next(i, u); ++i) {
        if (u.pm == T.pm0 || u.pm == T.pm1 || u.pm == T.pm2 || u.pm == T.pm3) continue;
        if (T.pm0 < 0) T.pm0 = u.pm; else if (T.pm1 < 0) T.pm1 = u.pm; else if (T.pm2 < 0) T.pm2 = u.pm; else T.pm3 = u.pm;
    }
    return T;
}
__device__ __forceinline__ void table_fill(const RstdTab& T, const TabJob j, int tid) {
    const int slot = tid >> 7, r2 = tid & 127;
    const int pm = (slot == 0) ? T.pm0 : (slot == 1) ? T.pm1 : (slot == 2) ? T.pm2 : T.pm3;
    if (pm >= 0) {
#pragma unroll
        for (int h = 0; h < 2; ++h) {
            const float* pp = j.src + (pm * BM + r2 + 128 * h); float sum = pp[0];
            if (j.mode == 1) {
#pragma unroll
                for (int q = 1; q < 16; ++q) sum += pp[(size_t)q * M]; }
            *((PG8_LAS float*)(T.lds + RT_OFF + slot * 1024) + r2 + 128 * h) = (j.mode == 3) ? sum : __builtin_amdgcn_rsqf(sum * (1.0f / 1024.0f) + 1e-6f);
        }
    }
    __syncthreads();
}
struct EpiInProj {
    static constexpr bool PERM = true, AFTER_DRAIN = false;
    RstdTab rt; unsigned char* wsb; size_t oQ, oK, oV, oU, oVV, oGL, oCT, oST; const float *qg, *kg; float qscale;
    __device__ __forceinline__ void operator()(const f32x4 (&acc)[2][2][4][2], const Unit& u, int wr, int wc, int fr, int fq) const {
        asm volatile("" : "+v"(fr), "+v"(fq));
        const int rowb = u.pm * BM + wr * 64 + fr, pn = u.pn;
        unsigned char* wl = wsb; asm volatile("" : "+s"(wl));
        bf16_t* const Q = (bf16_t*)(wl + oQ); bf16_t* const K = (bf16_t*)(wl + oK); bf16_t* const V = (bf16_t*)(wl + oV); bf16_t* const U = (bf16_t*)(wl + oU); bf16_t* const VV = (bf16_t*)(wl + oVV); bf16_t* const GL = (bf16_t*)(wl + oGL);
        const float* const ct = (const float*)(wl + oCT); const float* const st = (const float*)(wl + oST);
        float rs[2][4]; epi_rstd(rt, u.pm, wr * 64 + fr, rs);
        if (pn < 2 || (pn == 2 && wc < 2)) {
            const bool isq = pn < 2; const float* gn = isq ? qg : kg; const float qs = isq ? qscale : 1.0f;
            bf16_t* O = isq ? Q + 64 * (4 * pn + wc) : K + 64 * wc; const int ldo = isq ? 512 : 128;
            const int d00 = (fq < 2) ? 4 * fq : 8 * fq, d01 = (fq < 2) ? 8 + 4 * fq : 8 * fq + 4;
            const f32x4 g00 = *(const f32x4*)(gn + d00), g01 = *(const f32x4*)(gn + d01), g10 = *(const f32x4*)(gn + 32 + 8 * fq), g11 = *(const f32x4*)(gn + 36 + 8 * fq);
#pragma unroll
            for (int ai = 0; ai < 2; ++ai)
#pragma unroll
                for (int m = 0; m < 4; ++m) {
                    const int row = rowb + ai * HALF + m * 16; const float r = rs[ai][m];
                    f32x4 z00 = acc[ai][0][m][0] * r, z01 = acc[ai][0][m][1] * r, z10 = acc[ai][1][m][0] * r, z11 = acc[ai][1][m][1] * r;
                    const float ss = xsum_16_32((dot4(z00) + dot4(z01)) + (dot4(z10) + dot4(z11)));
                    const float r2 = __builtin_amdgcn_rsqf(ss * (1.0f / 64.0f) + 1e-6f);
                    z00 = z00 * r2 * g00; z01 = z01 * r2 * g01; z10 = z10 * (r2 * qs) * g10; z11 = z11 * (r2 * qs) * g11;
                    f32x4 c = *(const f32x4*)(ct + (size_t)row * 8 + 4 * (fq & 1)), s = *(const f32x4*)(st + (size_t)row * 8 + 4 * (fq & 1));
                    if (fq >= 2) { c = (f32x4){1.f, 1.f, 1.f, 1.f}; s = (f32x4){0.f, 0.f, 0.f, 0.f}; }
                    const f32x4 x1 = (z00 * c - z01 * s) * qs, x2 = (z01 * c + z00 * s) * qs;
                    bf16_t* op = O + (size_t)row * ldo + 8 * fq;
                    *(u32x4*)op = pack8(x1, x2); *(u32x4*)(op + 32) = pack8(z10, z11);
                    asm volatile("" ::: "memory");
                }
        } else if (pn == 2) {
            bf16_t* O = V + 64 * (wc - 2) + 8 * fq;
#pragma unroll
            for (int ai = 0; ai < 2; ++ai)
#pragma unroll
                for (int m = 0; m < 4; ++m) { const int row = rowb + ai * HALF + m * 16; const float r = rs[ai][m];
#pragma unroll
                    for (int bj = 0; bj < 2; ++bj) *(u32x4*)(O + (size_t)row * 128 + 32 * bj) = pack8(acc[ai][bj][m][0] * r, acc[ai][bj][m][1] * r); }
        } else if (pn < 5) {
            bf16_t* O = (pn == 3 ? U : VV) + wc * 32 + 8 * fq;
#pragma unroll
            for (int ai = 0; ai < 2; ++ai)
#pragma unroll
                for (int m = 0; m < 4; ++m) { const int row = rowb + ai * HALF + m * 16; const float r = rs[ai][m];
#pragma unroll
                    for (int bj = 0; bj < 2; ++bj) *(u32x4*)(O + (size_t)row * 256 + HALF * bj) = pack8(gelu4(acc[ai][bj][m][0] * r), gelu4(acc[ai][bj][m][1] * r)); }
        } else {
            bf16_t* O = GL + 128 * (pn - 5) + wc * 32 + 8 * fq;
#pragma unroll
            for (int ai = 0; ai < 2; ++ai)
#pragma unroll
                for (int m = 0; m < 4; ++m) { const int row = rowb + ai * HALF + m * 16; const float r = rs[ai][m];
                    const f32x4 a0 = acc[ai][0][m][0] * r, a1 = acc[ai][0][m][1] * r, g0 = acc[ai][1][m][0] * r, g1 = acc[ai][1][m][1] * r;
                    *(u32x4*)(O + (size_t)row * 256) = pack8(a0 * sigm4(g0), a1 * sigm4(g1)); }
        }
    }
};
struct EpiStore {
    static constexpr bool PERM = true, AFTER_DRAIN = false;
    bf16_t* O; int ldc;
    __device__ __forceinline__ void operator()(const f32x4 (&acc)[2][2][4][2], const Unit& u, int wr, int wc, int fr, int fq) const {
        asm volatile("" : "+v"(fr), "+v"(fq));
        const int rowb = u.pm * BM + wr * 64 + fr, colb = u.pn * BM + wc * 32 + 8 * fq;
#pragma unroll
        for (int ai = 0; ai < 2; ++ai)
#pragma unroll
            for (int m = 0; m < 4; ++m) { const int row = rowb + ai * HALF + m * 16;
#pragma unroll
                for (int bj = 0; bj < 2; ++bj) __builtin_nontemporal_store(pack8(acc[ai][bj][m][0], acc[ai][bj][m][1]), (u32x4*)((unsigned char*)O + tiled_off(row, 2 * (colb + HALF * bj), 2 * ldc))); }
    }
};
struct EpiGateUp {
    static constexpr bool PERM = true, AFTER_DRAIN = false;
    RstdTab rt; unsigned char* ACT;
    __device__ __forceinline__ void operator()(const f32x4 (&acc)[2][2][4][2], const Unit& u, int wr, int wc, int fr, int fq) const {
        asm volatile("" : "+v"(fr), "+v"(fq));
        const int rowb = u.pm * BM + wr * 64 + fr;
        float rs[2][4]; epi_rstd(rt, u.pm, wr * 64 + fr, rs);
        const int cb = 128 * u.pn + wc * 32 + 8 * fq; const bool f8t = 128 * u.pn < DOWN_K8;
        const int bc = f8t ? cb : DOWN_K8 + 2 * (cb - DOWN_K8);
#pragma unroll
        for (int ai = 0; ai < 2; ++ai)
#pragma unroll
            for (int m = 0; m < 4; ++m) { const int row = rowb + ai * HALF + m * 16; const float r = rs[ai][m];
                const float nrl = r * -1.4426950408889634f, r2 = r * r;
                const f32x4 ga = acc[ai][0][m][0], gb = acc[ai][0][m][1];
                const f32x4 ea = ga * nrl, eb = gb * nrl;
                const f32x4 da = (f32x4){__builtin_amdgcn_exp2f(ea[0]), __builtin_amdgcn_exp2f(ea[1]), __builtin_amdgcn_exp2f(ea[2]), __builtin_amdgcn_exp2f(ea[3])} + 1.0f;
                const f32x4 db = (f32x4){__builtin_amdgcn_exp2f(eb[0]), __builtin_amdgcn_exp2f(eb[1]), __builtin_amdgcn_exp2f(eb[2]), __builtin_amdgcn_exp2f(eb[3])} + 1.0f;
                const f32x4 ia = (f32x4){__builtin_amdgcn_rcpf(da[0]), __builtin_amdgcn_rcpf(da[1]), __builtin_amdgcn_rcpf(da[2]), __builtin_amdgcn_rcpf(da[3])} * r2;
                const f32x4 ib = (f32x4){__builtin_amdgcn_rcpf(db[0]), __builtin_amdgcn_rcpf(db[1]), __builtin_amdgcn_rcpf(db[2]), __builtin_amdgcn_rcpf(db[3])} * r2;
                const f32x4 va = (ga * acc[ai][1][m][0]) * ia, vb = (gb * acc[ai][1][m][1]) * ib;
                unsigned char* const O = ACT + tiled_off(row, bc, ACT_ROW_BYTES);
                if (f8t) *(u32x2_*)O = pack8_fp8(va, vb); else *(u32x4*)O = pack8(va, vb); }
    }
};
__device__ __forceinline__ f32x4 unpk_lo(const u32x4 w) { return (f32x4){__builtin_bit_cast(float, w.x << 16), __builtin_bit_cast(float, w.x & 0xffff0000u), __builtin_bit_cast(float, w.y << 16), __builtin_bit_cast(float, w.y & 0xffff0000u)}; }
__device__ __forceinline__ f32x4 unpk_hi(const u32x4 w) { return (f32x4){__builtin_bit_cast(float, w.z << 16), __builtin_bit_cast(float, w.z & 0xffff0000u), __builtin_bit_cast(float, w.w << 16), __builtin_bit_cast(float, w.w & 0xffff0000u)}; }
template <int MODE, bool OF32, bool ROWSC = false, bool X8 = false> struct EpiResid {
    static constexpr bool PERM = true, AFTER_DRAIN = false;
    const bf16_t* xin_bf; float* xout_f; bf16_t* xbf; const bf16_t* pj; RstdTab rt; float* part_out; unsigned char* x8;
    __device__ __forceinline__ void operator()(const f32x4 (&acc)[2][2][4][2], const Unit& u, int wr, int wc, int fr, int fq) const {
        asm volatile("" : "+v"(fr), "+v"(fq));
        const int rowb = u.pm * BM + wr * 64 + fr, colb = u.pn * BM + wc * 32 + 8 * fq;
        float rs[2][4];
        if (MODE == 1 || ROWSC) epi_rstd(rt, u.pm, wr * 64 + fr, rs);
        constexpr int PD = 2, NS = PD + 1;
        u32x4 xs[NS][2], ps[NS][2];
#define EPR_ISSUE(rg) do { const int row_ = rowb + ((rg) >> 2) * HALF + ((rg) & 3) * 16; _Pragma("unroll") for (int bj = 0; bj < 2; ++bj) { const size_t o_ = tiled_off(row_, 2 * (colb + HALF * bj), 2048); \
            xs[(rg) % NS][bj] = __builtin_nontemporal_load((const u32x4*)((const unsigned char*)xin_bf + o_)); if (MODE == 1) ps[(rg) % NS][bj] = __builtin_nontemporal_load((const u32x4*)((const unsigned char*)pj + o_)); } } while (0)
#pragma unroll
        for (int rg = 0; rg < PD; ++rg) EPR_ISSUE(rg);
#pragma unroll
        for (int rg = 0; rg < 8; ++rg) { const int ai = rg >> 2, m = rg & 3;
                if (rg + PD < 8) EPR_ISSUE(rg + PD);
                asm volatile("" ::: "memory");
                const int row = rowb + ai * HALF + m * 16; const size_t off = (size_t)row * 1024 + colb; float ss = 0.f;
#pragma unroll
                for (int bj = 0; bj < 2; ++bj) {
                    const size_t offt = tiled_off(row, 2 * (colb + HALF * bj), 2048);
                    const u32x4 xw = xs[rg % NS][bj];
                    const f32x4 x0 = unpk_lo(xw), x1 = unpk_hi(xw);
                    f32x4 o0, o1;
                    if (MODE == 0) { if (ROWSC || X8) { const float r = ROWSC ? rs[ai][m] : (1.0f / W8_SCALE); o0 = x0 + acc[ai][bj][m][0] * r; o1 = x1 + acc[ai][bj][m][1] * r; } else { o0 = x0 + acc[ai][bj][m][0]; o1 = x1 + acc[ai][bj][m][1]; } }
                    else { const u32x4 pw = ps[rg % NS][bj]; const float r = X8 ? rs[ai][m] * (1.0f / W8_SCALE) : rs[ai][m];
                        o0 = x0 + unpk_lo(pw) * sigm4(acc[ai][bj][m][0] * r); o1 = x1 + unpk_hi(pw) * sigm4(acc[ai][bj][m][1] * r); }
                    if (OF32) { __builtin_nontemporal_store(o0, (f32x4*)(xout_f + off + HALF * bj)); __builtin_nontemporal_store(o1, (f32x4*)(xout_f + off + HALF * bj + 4)); }
                    else *(u32x4*)((unsigned char*)xbf + offt) = pack8(o0, o1);
                    if (X8 && MODE == 0) *(u32x2_*)(x8 + tiled_off(row, colb + HALF * bj, 1024)) = pack8_fp8(o0, o1);
                    ss += dot4(o0) + dot4(o1);
                }
                if (!OF32) { ss = xsum_16_32(ss);
                    if (fq == 0) part_out[(size_t)(4 * u.pn + wc) * M + row] = ss; }
                asm volatile("" ::: "memory"); }
#undef EPR_ISSUE
    }
};
template <class Epi, class Sched, bool ALIGN_EPI = false, bool SP2 = false, int F8M = 0, bool ATILED = false>
__device__ __forceinline__ void gemm_phase(PG8_LAS unsigned char* lds, const Gemm g, const Sched& S, const Epi& E, const int tid_in, const TabJob tj = TabJob{nullptr, 0}, const RstdTab tab = RstdTab{-1, -1, -1, -1, nullptr}) {
    int tid_ = tid_in; asm volatile("" : "+v"(tid_));
    const int tid = tid_, wid = __builtin_amdgcn_readfirstlane(tid >> 6), lane = tid & 63, wr = wid >> 2, wc = wid & 3, fr = lane & 15, fq = lane >> 4;
    const int K = g.K, nt = K / BK;
    unsigned voffA[2], voffB[2];
#pragma unroll
    for (int i = 0; i < 2; ++i) { int R, C; stage_rc(tid * 16 + i * 8192, R, C); const int Rb = Epi::PERM ? ((R & ~31) + perm32(R & 31)) : R;
        voffA[i] = ATILED ? (unsigned)tiled_off(R, 2 * C, 2 * K) : (unsigned)(R * K + C) * 2u; voffB[i] = (unsigned)(Rb * K + C) * 2u; }
    const size_t kstep = (size_t)(BK * 2), kstepA = ATILED ? (size_t)2048 : kstep;
    const size_t hstep = (size_t)HALF * K * 2;
    const size_t tstep = 2 * hstep;
    const unsigned ldsw = (unsigned)wid * 1024u;
    const int aoff = lds_byte(wr * 64 + fr, fq * 8), boff = lds_byte(wc * 32 + fr, fq * 8);
#define PG8_SA(b, h) (((b) * 2 + (h)) * HTB)
#define PG8_SB(b, h) ((4 + (b) * 2 + (h)) * HTB)
#define PG8_STAGE(bufoff, gbase, voff) do { _Pragma("unroll") for (int _i = 0; _i < 2; ++_i) \
        __builtin_amdgcn_global_load_lds((const unsigned*)((const char*)(gbase) + (voff)[_i]), (PG8_LAS unsigned*)(lds + (bufoff) + ldsw + _i * 8192), 16, 0, 0); } while (0)
#define PG8_LDA(dst, b, h) do { _Pragma("unroll") for (int m = 0; m < 4; ++m) _Pragma("unroll") for (int k = 0; k < 2; ++k) dst[m][k] = *(const PG8_LAS bf16x8*)(lds + PG8_SA(b, h) + aoff + m * 2048 + k * 1024); } while (0)
#define PG8_LDB(dst, b, h) do { _Pragma("unroll") for (int n = 0; n < 2; ++n) _Pragma("unroll") for (int k = 0; k < 2; ++k) dst[n][k] = *(const PG8_LAS bf16x8*)(lds + PG8_SB(b, h) + boff + n * 2048 + k * 1024); } while (0)
#define PG8_MMA(F8T, ai, bj, At, Bt) do { __builtin_amdgcn_s_setprio(1); _Pragma("unroll") for (int m = 0; m < 4; ++m) _Pragma("unroll") for (int n = 0; n < 2; ++n) { \
        if constexpr (F8T) mfma_f8_acc(acc[ai][bj][m][n], cat8(Bt[n][0], Bt[n][1]), cat8(At[m][0], At[m][1])); \
        else { _Pragma("unroll") for (int k = 0; k < 2; ++k) acc[ai][bj][m][n] = __builtin_amdgcn_mfma_f32_16x16x32_bf16(Bt[n][k], At[m][k], acc[ai][bj][m][n], 0, 0, 0); } } __builtin_amdgcn_s_setprio(0); } while (0)
#define PG8_WAIT_V(n) asm volatile("s_waitcnt vmcnt(" #n ")" ::: "memory")
#define PG8_WAIT_L(n) asm volatile("s_waitcnt lgkmcnt(" #n ")" ::: "memory")
#define PG8_BAR __builtin_amdgcn_s_barrier()
#define PG8_SCHED __builtin_amdgcn_sched_barrier(0)
    Unit cur, nxt; int ui = 0;
    if (!S.next(0, cur)) return;
    f32x4 acc[2][2][4][2];
#pragma unroll
    for (int a = 0; a < 2; ++a)
#pragma unroll
        for (int b = 0; b < 2; ++b)
#pragma unroll
            for (int m = 0; m < 4; ++m)
#pragma unroll
                for (int n = 0; n < 2; ++n) acc[a][b][m][n] = (f32x4){0.f, 0.f, 0.f, 0.f};
    bf16x8 At[4][2], B0[2][2], B1[2][2];
    const char* cA = (const char*)g.A + (size_t)cur.pm * tstep; const char* cB = (const char*)g.Bt + (size_t)cur.pn * tstep;
    S.a_ready(cur);
    if constexpr (SP2) {
        PG8_STAGE(PG8_SB(0, 0), cB, voffB); PG8_STAGE(PG8_SB(0, 1), cB + hstep, voffB); PG8_STAGE(PG8_SA(0, 0), cA, voffA); PG8_STAGE(PG8_SA(0, 1), cA + hstep, voffA);
        if (tj.mode) table_fill(tab, tj, tid);
        if (wr == 1) PG8_BAR;
        PG8_WAIT_V(2); PG8_BAR;
        PG8_STAGE(PG8_SB(1, 0), cB + kstep, voffB); PG8_STAGE(PG8_SA(1, 0), cA + kstepA, voffA); PG8_STAGE(PG8_SB(1, 1), cB + hstep + kstep, voffB);
        PG8_WAIT_V(6); PG8_BAR;
    } else {
        PG8_STAGE(PG8_SB(0, 0), cB, voffB); PG8_STAGE(PG8_SA(0, 0), cA, voffA); PG8_STAGE(PG8_SB(0, 1), cB + hstep, voffB); PG8_STAGE(PG8_SA(0, 1), cA + hstep, voffA);
        if (wr == 1) PG8_BAR;
        PG8_WAIT_V(4); PG8_BAR;
        PG8_STAGE(PG8_SB(1, 0), cB + kstep, voffB); PG8_STAGE(PG8_SA(1, 0), cA + kstepA, voffA); PG8_STAGE(PG8_SB(1, 1), cB + hstep + kstep, voffB);
        PG8_WAIT_V(6); PG8_BAR;
    }
    for (;;) {
        const bool has_next = S.next(ui + 1, nxt);
        const char* nA = has_next ? (const char*)g.A + (size_t)nxt.pm * tstep : cA; const char* nB = has_next ? (const char*)g.Bt + (size_t)nxt.pn * tstep : cB;
        auto kpair = [&](auto f8t_, const int t) __attribute__((always_inline)) { constexpr bool F8T = decltype(f8t_)::value;
            const bool last = (t == nt - 2);
            const char* a1 = cA + (size_t)(t + 1) * kstepA;
            const char* a2 = last ? nA : cA + (size_t)(t + 2) * kstepA; const char* b2 = last ? nB : cB + (size_t)(t + 2) * kstep;
            const char* a3 = a2 + kstepA; const char* b3 = b2 + kstep;
            if (last && has_next) S.a_ready(nxt);
            if constexpr (SP2) {
            PG8_LDB(B0, 0, 0); PG8_LDB(B1, 0, 1); PG8_SCHED; PG8_LDA(At, 0, 0); PG8_STAGE(PG8_SA(1, 1), a1 + hstep, voffA);
            PG8_WAIT_V(8); PG8_WAIT_L(0); PG8_BAR; PG8_MMA(F8T, 0, 0, At, B0); PG8_MMA(F8T, 0, 1, At, B1); PG8_BAR; PG8_SCHED;
            PG8_LDA(At, 0, 1); PG8_STAGE(PG8_SB(0, 0), b2, voffB); PG8_STAGE(PG8_SB(0, 1), b2 + hstep, voffB); PG8_STAGE(PG8_SA(0, 0), a2, voffA);
            PG8_WAIT_V(8); PG8_WAIT_L(0); PG8_BAR; PG8_MMA(F8T, 1, 0, At, B0); PG8_MMA(F8T, 1, 1, At, B1); PG8_BAR; PG8_SCHED;
            PG8_LDB(B0, 1, 0); PG8_LDB(B1, 1, 1); PG8_SCHED; PG8_LDA(At, 1, 0); PG8_STAGE(PG8_SA(0, 1), a2 + hstep, voffA);
            PG8_WAIT_V(8); PG8_WAIT_L(0); PG8_BAR; PG8_MMA(F8T, 0, 0, At, B0); PG8_MMA(F8T, 0, 1, At, B1); PG8_BAR; PG8_SCHED;
            PG8_LDA(At, 1, 1); PG8_STAGE(PG8_SB(1, 0), b3, voffB); PG8_STAGE(PG8_SB(1, 1), b3 + hstep, voffB); PG8_STAGE(PG8_SA(1, 0), a3, voffA);
            PG8_WAIT_V(8); PG8_WAIT_L(0); PG8_BAR; PG8_MMA(F8T, 1, 0, At, B0); PG8_MMA(F8T, 1, 1, At, B1); PG8_BAR; PG8_SCHED;
            } else {
            PG8_LDB(B0, 0, 0); PG8_SCHED; PG8_LDA(At, 0, 0); PG8_STAGE(PG8_SA(1, 1), a1 + hstep, voffA);
            PG8_WAIT_L(8); PG8_BAR; PG8_WAIT_L(0); PG8_MMA(F8T, 0, 0, At, B0); PG8_BAR; PG8_SCHED;
            PG8_LDB(B1, 0, 1); PG8_STAGE(PG8_SB(0, 0), b2, voffB);
            PG8_BAR; PG8_WAIT_L(0); PG8_MMA(F8T, 0, 1, At, B1); PG8_BAR;
            PG8_LDA(At, 0, 1); PG8_STAGE(PG8_SA(0, 0), a2, voffA);
            PG8_BAR; PG8_WAIT_L(0); PG8_MMA(F8T, 1, 0, At, B0); PG8_BAR; PG8_SCHED;
            PG8_STAGE(PG8_SB(0, 1), b2 + hstep, voffB);
            PG8_WAIT_V(6); PG8_BAR; PG8_MMA(F8T, 1, 1, At, B1); PG8_BAR;
            PG8_LDB(B0, 1, 0); PG8_SCHED; PG8_LDA(At, 1, 0); PG8_STAGE(PG8_SA(0, 1), a2 + hstep, voffA);
            PG8_WAIT_L(8); PG8_BAR; PG8_WAIT_L(0); PG8_MMA(F8T, 0, 0, At, B0); PG8_BAR; PG8_SCHED;
            PG8_LDB(B1, 1, 1); PG8_STAGE(PG8_SB(1, 0), b3, voffB);
            PG8_BAR; PG8_WAIT_L(0); PG8_MMA(F8T, 0, 1, At, B1); PG8_BAR;
            PG8_LDA(At, 1, 1); PG8_STAGE(PG8_SA(1, 0), a3, voffA);
            PG8_BAR; PG8_WAIT_L(0); PG8_MMA(F8T, 1, 0, At, B0); PG8_BAR; PG8_SCHED;
            PG8_STAGE(PG8_SB(1, 1), b3 + hstep, voffB);
            PG8_WAIT_V(6); PG8_BAR; PG8_MMA(F8T, 1, 1, At, B1); PG8_BAR;
            }
        };
        if constexpr (F8M == 1) { for (int t = 0; t < nt; t += 2) kpair(std::true_type{}, t); }
        else if constexpr (F8M == 2) { int t = 0; for (; t < g.nt8; t += 2) kpair(std::true_type{}, t); for (; t < nt; t += 2) kpair(std::false_type{}, t); }
        else { for (int t = 0; t < nt; t += 2) kpair(std::false_type{}, t); }
        if constexpr (F8M == 1) asm volatile("s_nop 15\n\ts_nop 7" ::: "memory");
        if constexpr (ALIGN_EPI) { if (wr == 0) PG8_BAR; }
        if constexpr (!Epi::AFTER_DRAIN) { E(acc, cur, wr, wc, fr, fq); S.done(cur); }
        if (!has_next) break;
#pragma unroll
        for (int a = 0; a < 2; ++a)
#pragma unroll
            for (int b = 0; b < 2; ++b)
#pragma unroll
                for (int m = 0; m < 4; ++m)
#pragma unroll
                    for (int n = 0; n < 2; ++n) acc[a][b][m][n] = (f32x4){0.f, 0.f, 0.f, 0.f};
        cur = nxt; cA = nA; cB = nB; ++ui;
        if constexpr (ALIGN_EPI) { if (wr == 1) PG8_BAR; }
    }
    PG8_WAIT_V(0);
    if constexpr (!ALIGN_EPI) { if (wr == 0) PG8_BAR; }
    PG8_BAR;
    if constexpr (Epi::AFTER_DRAIN) { E.fused(acc, cur, wr, wc, fr, fq, lds, wid, lane); S.done(cur); }
#undef PG8_SA
#undef PG8_SB
#undef PG8_STAGE
#undef PG8_LDA
#undef PG8_LDB
#undef PG8_MMA
#undef PG8_WAIT_V
#undef PG8_WAIT_L
#undef PG8_BAR
#undef PG8_SCHED
}
}

constexpr int NWAVES = 8;
constexpr int RING_BYTES = 131072, LDS_BYTES = 163840, LDSCTL_OFF = LDS_BYTES - 1024, MISC_OFF = LDSCTL_OFF + 320;

struct Args { const void* in[N_IN]; float* out; unsigned char* ws; int st_lo, st_hi, li, pad; };

struct Ctx {
    const Args* a; unsigned char* ws; float* out;
    int tid, lane, wave, gw, ngw, gtid, ngt;
    LAS unsigned char* lds;
    __device__ __forceinline__ const float* fin(int i, size_t off = 0) const { return (const float*)a->in[i] + off; }
};

__device__ __forceinline__ void dsincos(double r, double& s, double& c) {
    const double r2 = r * r;
    double ts = 1.0, tc = 1.0;
#pragma unroll
    for (int k = 14; k >= 1; --k) { ts = 1.0 - ts * r2 * (1.0 / (double)((2 * k) * (2 * k + 1))); tc = 1.0 - tc * r2 * (1.0 / (double)((2 * k - 1) * (2 * k))); }
    s = r * ts; c = tc;
}
__device__ __forceinline__ void step_prologue(const Ctx& C) {
    {
        const float* x = C.fin(I_X);
        bf16* xbf = (bf16*)(C.ws + WS_XBF); float* part = (float*)(C.ws + WS_PARTA);
        constexpr int RPW = 4;
        for (int m0 = C.gw * RPW; m0 < M; m0 += C.ngw * RPW) {
            f32x4 v[RPW][4]; float srow = 0.f;
#pragma unroll
            for (int r = 0; r < RPW; ++r)
#pragma unroll
                for (int j = 0; j < 4; ++j) v[r][j] = __builtin_nontemporal_load((const f32x4*)(x + (size_t)(m0 + r) * D_MODEL) + C.lane + 64 * j);
#pragma unroll
            for (int r = 0; r < RPW; ++r) {
                float s = 0.f;
#pragma unroll
                for (int j = 0; j < 4; ++j) { const f32x4 t = v[r][j]; s += (t.x * t.x + t.y * t.y) + (t.z * t.z + t.w * t.w); u32x2 w; w.x = pk2(t.x, t.y); w.y = pk2(t.z, t.w); *(u32x2*)((unsigned char*)xbf + tiled_off(m0 + r, 8 * (C.lane + 64 * j), 2 * D_MODEL)) = w; }
                s = wave_sum(s); srow = (C.lane == r) ? s : srow;
            }
            if (C.lane < RPW) part[m0 + C.lane] = srow;
        }
    }
    {
        const f32x4* p4 = (const f32x4*)C.fin(I_P); u32x2* o = (u32x2*)(C.ws + WS_PBF);
        constexpr size_t n4 = (size_t)DEPTH * M * PLE_DIM / 4;
        for (size_t i0 = C.gtid; i0 < n4; i0 += (size_t)C.ngt * 8) {
            f32x4 v[8];
#pragma unroll
            for (int k = 0; k < 8; ++k) { const size_t i = i0 + (size_t)k * C.ngt; v[k] = __builtin_nontemporal_load(p4 + (i < n4 ? i : n4 - 1)); }
#pragma unroll
            for (int k = 0; k < 8; ++k) { const size_t i = i0 + (size_t)k * C.ngt; if (i < n4) { u32x2 w; w.x = pk2(v[k].x, v[k].y); w.y = pk2(v[k].z, v[k].w); if (i >= n4 / 2) __builtin_nontemporal_store(w, o + i); else o[i] = w; } }
        }
    }
    {
        const int* pos = (const int*)C.a->in[I_POS]; float* ct = (float*)(C.ws + WS_COS); float* st = (float*)(C.ws + WS_SIN);
        const float invf[8] = {1.0f, 0.1939227432012558f, 0.03760603070259094f, 0.007292664609849453f, 0.0014142135623842478f, 0.00027424818836152554f, 5.318296098266728e-05f, 1.0313386155758053e-05f};
        for (int i = C.gtid; i < M * 8; i += C.ngt) {
            const int m = i >> 3, j = i & 7;
            float fr = 1.0f;
#pragma unroll
            for (int q = 0; q < 8; ++q) fr = (j == q) ? invf[q] : fr;
            const float ang = (float)pos[m] * fr;
            const double a = (double)ang, k = __builtin_rint(a * 0.15915494309189535);
            const double r = (a - k * 6.283185307179586) - k * 2.4492935982947064e-16;
            double s, c; dsincos(r, s, c);
            ct[i] = (float)c; st[i] = (float)s;
        }
    }
}

__device__ __forceinline__ int dperm16(int e) { return (e < 16) ? (8 * ((e >> 2) & 1) + 4 * (e >> 3) + (e & 3)) : e; }
template <bool F8 = false>
__device__ __forceinline__ void wprep_item(const float* __restrict__ W, int ldw, const float* __restrict__ gain, unsigned char* WT, size_t rowbytes, int kbyte0, float scale, int k0, int nsrc0, int drow0, bool permq, LAS float* scr, int lane, bool later = false) {
    float wv[32];
#pragma unroll
    for (int i = 0; i < 32; ++i) { const int kk = 2 * i + (lane >> 5); wv[i] = __builtin_nontemporal_load(W + (size_t)(k0 + kk) * ldw + nsrc0 + (lane & 31)); }
#pragma unroll
    for (int i = 0; i < 32; ++i) { const int kk = 2 * i + (lane >> 5); const float g = gain ? gain[k0 + kk] * scale : scale; scr[kk * 33 + (lane & 31)] = wv[i] * g; }
    asm volatile("s_waitcnt lgkmcnt(0)" ::: "memory");
    const int c = lane & 7;
#pragma unroll
    for (int j = 0; j < 4; ++j) { const int e = (lane >> 3) + 8 * j, sc = permq ? dperm16(e) : e; const LAS float* sp = scr + (8 * c) * 33 + sc;
        unsigned char* dst = WT + (size_t)(drow0 + e) * rowbytes + kbyte0;
        if constexpr (F8) { const u32x2 o8 = pg8::pack8_fp8((f32x4){sp[0 * 33], sp[1 * 33], sp[2 * 33], sp[3 * 33]}, (f32x4){sp[4 * 33], sp[5 * 33], sp[6 * 33], sp[7 * 33]});
            if (later) __builtin_nontemporal_store(o8, (u32x2*)(dst + 8 * c)); else *(u32x2*)(dst + 8 * c) = o8; }
        else { u32x4 o; o.x = pk2(sp[0 * 33], sp[1 * 33]); o.y = pk2(sp[2 * 33], sp[3 * 33]); o.z = pk2(sp[4 * 33], sp[5 * 33]); o.w = pk2(sp[6 * 33], sp[7 * 33]);
            if (later) __builtin_nontemporal_store(o, (u32x4*)(dst + 16 * c)); else *(u32x4*)(dst + 16 * c) = o; } }
    asm volatile("s_waitcnt lgkmcnt(0)" ::: "memory");
}
__device__ __forceinline__ void inproj_src(int gi, int& nsrc0, bool& permq) {
    const int c0 = 32 * gi, pn = c0 >> 8, r = c0 & 255, bj = r >> 7, wc = (r >> 5) & 3;
    permq = false;
    if (pn < 2) { nsrc0 = Q_OFF + 64 * (4 * pn + wc) + 32 * bj; permq = (bj == 0); }
    else if (pn == 2) { if (wc < 2) { nsrc0 = K_OFF + 64 * wc + 32 * bj; permq = (bj == 0); } else nsrc0 = V_OFF + 64 * (wc - 2) + 32 * bj; }
    else if (pn == 3) nsrc0 = GM_OFF + r;
    else if (pn == 4) nsrc0 = GM_OFF + 256 + r;
    else nsrc0 = CONV_OFF + 256 * bj + 128 * (pn - 5) + 32 * wc;
}
__device__ __forceinline__ void step_wprep(const Ctx& C) {
    LAS float* scr = (LAS float*)(C.lds + C.wave * 16384);
    constexpr int I_IN = 16 * (IN_COLS / 32), I_OUT = 16 * 32, I_GU = 16 * (2 * D_FF / 32), I_DOWN = (D_FF / 64) * 32, I_PG = 16 * 32, I_PP = 4 * 32, I_LAYER = I_IN + I_OUT + I_GU + I_DOWN + I_PG + I_PP;
    for (int it = C.gw; it < DEPTH * I_LAYER; it += C.ngw) {
        const int l = it / I_LAYER; int r = it % I_LAYER;
        bf16* WL = (bf16*)(C.ws + WS_W + (size_t)l * W_LAYER);
        if (r < I_IN) { const int gi = r % (IN_COLS / 32), kb = r / (IN_COLS / 32); int ns; bool pq; inproj_src(gi, ns, pq);
            wprep_item(C.fin(I_W_IN, (size_t)l * D_MODEL * IN_COLS), IN_COLS, C.fin(I_NORM_MIX_G, (size_t)l * D_MODEL), (unsigned char*)WL + WO_IN, D_MODEL * 2, 128 * kb, 1.0f, 64 * kb, ns, 32 * gi, pq, scr, C.lane, l > 0); continue; } r -= I_IN;
        if (r < I_OUT) { const int gi = r % 32, kb = r / 32;
            wprep_item(C.fin(I_W_OUT, (size_t)l * D_MODEL * D_MODEL), D_MODEL, C.fin(I_OUT_NORM_G, (size_t)l * D_MODEL), (unsigned char*)WL + WO_OUT, D_MODEL * 2, 128 * kb, 1.0f, 64 * kb, 32 * gi, 32 * gi, false, scr, C.lane, true); continue; } r -= I_OUT;
        if (r < I_GU) { const int gi = r % (2 * D_FF / 32), kb = r / (2 * D_FF / 32); const int c0 = 32 * gi, pn = c0 >> 8, rr = c0 & 255, bj = rr >> 7;
            wprep_item(C.fin(I_W_GU, (size_t)l * D_MODEL * 2 * D_FF), 2 * D_FF, C.fin(I_NORM_FFN_G, (size_t)l * D_MODEL), (unsigned char*)WL + WO_GU, D_MODEL * 2, 128 * kb, 1.0f, 64 * kb, bj * D_FF + 128 * pn + (rr & 127), 32 * gi, false, scr, C.lane, true); continue; } r -= I_GU;
        if (r < I_DOWN) { const int gi = r % 32, kb = r / 32;
            if (64 * kb < DOWN_K8) wprep_item<true>(C.fin(I_W_DOWN, (size_t)l * D_FF * D_MODEL), D_MODEL, nullptr, (unsigned char*)WL + WO_DOWN, ACT_ROW_BYTES, 64 * kb, pg8::W8_SCALE, 64 * kb, 32 * gi, 32 * gi, false, scr, C.lane, true);
            else wprep_item(C.fin(I_W_DOWN, (size_t)l * D_FF * D_MODEL), D_MODEL, nullptr, (unsigned char*)WL + WO_DOWN, ACT_ROW_BYTES, DOWN_K8 + 2 * (64 * kb - DOWN_K8), pg8::W8_SCALE, 64 * kb, 32 * gi, 32 * gi, false, scr, C.lane, true); continue; } r -= I_DOWN;
        if (r < I_PG) { const int gi = r % 32, kb = r / 32;
            wprep_item<true>(C.fin(I_W_PG, (size_t)l * D_MODEL * D_MODEL), D_MODEL, C.fin(I_PLE_NORM_G, (size_t)l * D_MODEL), (unsigned char*)WL + WO_PG, D_MODEL, 64 * kb, pg8::W8_SCALE, 64 * kb, 32 * gi, 32 * gi, false, scr, C.lane, true); continue; } r -= I_PG;
        { const int gi = r % 32, kb = r / 32;
            wprep_item(C.fin(I_W_PP, (size_t)l * PLE_DIM * D_MODEL), D_MODEL, nullptr, (unsigned char*)WL + WO_PP, PLE_DIM * 2, 128 * kb, 1.0f, 64 * kb, 32 * gi, 32 * gi, false, scr, C.lane, l > 0); }
    }
    {
        const f32x4* w4 = (const f32x4*)C.fin(I_GM_WS); u32x2* o = (u32x2*)(C.ws + WS_WSBF);
        for (int i = C.gtid; i < DEPTH * GM_HEADS * CHUNK * CHUNK / 4; i += C.ngt) { const f32x4 v = w4[i]; u32x2 w; w.x = pk2(v.x, v.y); w.y = pk2(v.z, v.w); o[i] = w; }
    }
}

__device__ __forceinline__ const pg8::bf16_t* wcopy(const Ctx& C, int l, size_t off) { return (const pg8::bf16_t*)(C.ws + WS_W + (size_t)l * W_LAYER + off); }
struct PjOrder {
    int c, G;
    __device__ __forceinline__ bool next(int i, pg8::Unit& u) const {
        constexpr int NU = (M / 256) * (D_MODEL / 256);
        if (G == 256) { const int pnl = 16 * (c & 7) + ((c >> 3) & 7) + 8 * ((c >> 6) & 1);
            if (c < 128) { if (i >= 1) return false; u.pm = pnl; u.pn = 3; return true; } if (i >= 3) return false; u.pm = pnl; u.pn = i; return true; }
        const int L = i * G + c; if (L >= NU) return false; u.pm = L >> 2; u.pn = L & 3; return true;
    }
    __device__ __forceinline__ void a_ready(const pg8::Unit&) const {}
    __device__ __forceinline__ void done(const pg8::Unit&) const {}
};
__device__ __forceinline__ void step_inproj_opt(const Ctx& C, int l, const float* part) {
    {
        pg8::Gemm g{(const pg8::bf16_t*)(C.ws + (l == 0 ? WS_XBF : WS_XBF2)), wcopy(C, l, WO_IN), M, IN_COLS, D_MODEL};
        pg8::StaticOrder S; S.init(M, IN_COLS, (int)gridDim.x, (int)blockIdx.x);
        const pg8::RstdTab rt = pg8::table_slots(C.lds, S); const pg8::TabJob tj{part, l == 0 ? 2 : 1};
        pg8::EpiInProj E{rt, C.ws, WS_Q, WS_K, WS_V, WS_U, WS_VV, WS_GLU, WS_COS, WS_SIN, C.fin(I_QG, l * 64), C.fin(I_KG, l * 64), C2};
        pg8::gemm_phase<pg8::EpiInProj, pg8::StaticOrder, true, true, 0, true>(C.lds, g, S, E, C.tid, tj, rt);
    }
    {
        pg8::Gemm g{(const pg8::bf16_t*)(C.ws + WS_PBF) + (size_t)l * M * PLE_DIM, wcopy(C, l, WO_PP), M, D_MODEL, PLE_DIM};
        PjOrder S; S.c = (int)blockIdx.x; S.G = (int)gridDim.x;
        pg8::EpiStore E{(pg8::bf16_t*)(C.ws + WS_PJ), D_MODEL};
        pg8::gemm_phase<pg8::EpiStore, PjOrder, false, true>(C.lds, g, S, E, C.tid);
    }
}
template <int MODE, bool OF32, bool ROWSC = false, bool X8 = false>
__device__ __forceinline__ void step_resid_opt(const Ctx& C, const bf16* A, int K, const pg8::bf16_t* Bt, const bf16* xin_bf, bf16* xbf_out, const float* part_in, float* part_out) {
    pg8::Gemm g{(const pg8::bf16_t*)A, Bt, M, D_MODEL, K};
    pg8::StaticOrder S; S.init(M, D_MODEL, (int)gridDim.x, (int)blockIdx.x);
    pg8::RstdTab rt; rt.pm0 = rt.pm1 = rt.pm2 = rt.pm3 = -1; rt.lds = C.lds; pg8::TabJob tj{nullptr, 0};
    if (MODE == 1) { rt = pg8::table_slots(C.lds, S); tj = pg8::TabJob{part_in, 1}; }
    if (ROWSC) { rt = pg8::table_slots(C.lds, S); tj = pg8::TabJob{(const float*)(C.ws + WS_ARSTD), 3}; }
    pg8::EpiResid<MODE, OF32, ROWSC, X8> E{(const pg8::bf16_t*)xin_bf, C.out, (pg8::bf16_t*)xbf_out, (const pg8::bf16_t*)(C.ws + WS_PJ), rt, part_out, C.ws + WS_X8};
    constexpr int F8M = X8 ? (MODE == 1 ? 1 : 2) : 0;
    if (F8M == 2) g.nt8 = DOWN_K8 / 128;
    pg8::gemm_phase<pg8::EpiResid<MODE, OF32, ROWSC, X8>, pg8::StaticOrder, true, true, F8M, X8>(C.lds, g, S, E, C.tid, tj, rt);
}
__device__ __forceinline__ void step_gateup_opt(const Ctx& C, int l, const float* part) {
    pg8::Gemm g{(const pg8::bf16_t*)(C.ws + WS_XBF), wcopy(C, l, WO_GU), M, 2 * D_FF, D_MODEL};
    pg8::StaticOrder S; S.init(M, 2 * D_FF, (int)gridDim.x, (int)blockIdx.x);
    const pg8::RstdTab rt = pg8::table_slots(C.lds, S); const pg8::TabJob tj{part, 1};
    pg8::EpiGateUp E{rt, C.ws + WS_ACT};
    pg8::gemm_phase<pg8::EpiGateUp, pg8::StaticOrder, true, true, 0, true>(C.lds, g, S, E, C.tid, tj, rt);
}


typedef short bf16x8_t __attribute__((ext_vector_type(8)));
__device__ __forceinline__ f32x4 mfma16(const bf16x8_t a, const bf16x8_t b, const f32x4 c) { return __builtin_amdgcn_mfma_f32_16x16x32_bf16(a, b, c, 0, 0, 0); }
__device__ __forceinline__ unsigned cvtpk(float lo, float hi) { unsigned r; asm volatile("s_nop 1\n\tv_cvt_pk_bf16_f32 %0, %1, %2" : "=v"(r) : "v"(lo), "v"(hi)); return r; }
__device__ __forceinline__ u32x2 cvtpk2(const f32x4 p) { u32x2 r; asm volatile("s_nop 1\n\tv_cvt_pk_bf16_f32 %0, %2, %3\n\tv_cvt_pk_bf16_f32 %1, %4, %5" : "=&v"(r.x), "=&v"(r.y) : "v"(p.x), "v"(p.y), "v"(p.z), "v"(p.w)); return r; }
__device__ __forceinline__ float rsq_(float x) { return __builtin_amdgcn_rsqf(x); }
constexpr int CV_G = 0, CV_GROW = 512, CV_Y = 49152, CV_YROW = 1024, CV_W = 114688;
static_assert(CV_W + CONV_W * CONV_CH * 4 <= LDSCTL_OFF, "conv scratch below the LDS control words");
constexpr int GM_T = 0, GM_TROW = 272, GM_ST = 69632;
constexpr int AT_K = 0, AT_KROW = 128, AT_V = 49152, AT_VROW = 904, AT_O = 107008, AT_OROW = 272;
constexpr int MX_RA = 162304;
static_assert(AT_O + NWAVES * 16 * AT_OROW <= MX_RA && MX_RA + 512 <= LDSCTL_OFF, "mixer LDS map");
constexpr int AT_K_ = 0;
__device__ __forceinline__ void step_mixer_opt(const Ctx& C, int l) {
    const int w = C.wave;
    LAS unsigned char* const L = C.lds;
#define MIX_LANES() int tid = w * 64 + lane_id(); asm volatile("" : "+v"(tid)); const int lane = tid & 63, l15 = lane & 15, h4 = lane >> 4; (void)l15; (void)h4
    bf16* const MG = (bf16*)(C.ws + WS_MERGED);
    const int unit0 = (gridDim.x == 256) ? 2 * (16 * ((int)blockIdx.x & 7) + (((int)blockIdx.x >> 3) & 7) + 8 * ((int)blockIdx.x >> 7)) + (((int)blockIdx.x >> 6) & 1) : (int)blockIdx.x;
    for (int rep_mix = 0; rep_mix < REP_MIX; ++rep_mix)
    for (int unit = unit0; unit < M / CHUNK; unit += gridDim.x) {
        const int m0 = unit * CHUNK, tpos0 = m0 & (SEQ - 1);
        {
            MIX_LANES();
            const bf16* Q = (const bf16*)(C.ws + WS_Q); const bf16* Kb = (const bf16*)(C.ws + WS_K); const bf16* V = (const bf16*)(C.ws + WS_V);
            const float* sink = C.fin(I_SINK, l * NQH);
            const int cidx = tpos0 >> 7;
            const bool edge = (cidx == 0) || (cidx == SEQ / CHUNK - 1);
            const int kb_lo = (cidx == 0) ? 8 - w : 0, kb_hi = (cidx == SEQ / CHUNK - 1) ? 16 - w : 17;
            const size_t qrow = (size_t)(m0 + 16 * w + l15);
            float ssq = 0.f;
            float bref; { const float gq = fabsf(C.fin(I_QG, l * 64)[lane]), gk = fabsf(C.fin(I_KG, l * 64)[lane]);
                float a = gq, b = gk;
                a = fmaxf(a, dpp_(a, 0xB1, 0xf, true)); a = fmaxf(a, dpp_(a, 0x4E, 0xf, true)); a = fmaxf(a, dpp_(a, 0x141, 0xf, true)); a = fmaxf(a, dpp_(a, 0x140, 0xf, true)); a = xmax_16_32(a);
                b = fmaxf(b, dpp_(b, 0xB1, 0xf, true)); b = fmaxf(b, dpp_(b, 0x4E, 0xf, true)); b = fmaxf(b, dpp_(b, 0x141, 0xf, true)); b = fmaxf(b, dpp_(b, 0x140, 0xf, true)); b = xmax_16_32(b);
                bref = __builtin_bit_cast(float, __builtin_amdgcn_readfirstlane(__builtin_bit_cast(int, 64.0f * C2 * 1.02f * a * b))); }
            const bool fast_ref = bref <= 32.0f;
            const f32x4 negB = (f32x4){-bref, -bref, -bref, -bref};
            const bf16x8_t ones8 = (bf16x8_t){(short)0x3f80, (short)0x3f80, (short)0x3f80, (short)0x3f80, (short)0x3f80, (short)0x3f80, (short)0x3f80, (short)0x3f80};
#pragma unroll 1
            for (int g = 0; g < 2; ++g) {
                {
                    u32x4 kq[6], vq[6];
#pragma unroll
                    for (int it = 0; it < 6; ++it) {
                        const int i = tid + it * (NWAVES * 64);
                        { const int R = i >> 3, ch = i & 7, tp = tpos0 - WINDOW + R, tpc = tp < 0 ? 0 : (tp > SEQ - 1 ? SEQ - 1 : tp);
                          kq[it] = *(const u32x4*)(Kb + (size_t)(m0 - tpos0 + tpc) * 128 + 64 * g + 8 * ch); if (tp != tpc) kq[it] = (u32x4){0u, 0u, 0u, 0u}; }
                        { const int R = i % 384, ch = i / 384, tp = tpos0 - WINDOW + R, tpc = tp < 0 ? 0 : (tp > SEQ - 1 ? SEQ - 1 : tp);
                          vq[it] = *(const u32x4*)(V + (size_t)(m0 - tpos0 + tpc) * 128 + 64 * g + 8 * ch); if (tp != tpc) vq[it] = (u32x4){0u, 0u, 0u, 0u}; }
                    }
#pragma unroll
                    for (int it = 0; it < 6; ++it) {
                        const int i = tid + it * (NWAVES * 64);
                        { const int R = i >> 3, ch = i & 7; *(LAS u32x4*)(L + AT_K + R * AT_KROW + ((ch ^ (R & 7)) * 16)) = kq[it]; }
                        { const int R = i % 384, ch = i / 384;
                          LAS unsigned short* vp = (LAS unsigned short*)(L + AT_V + (8 * ch) * AT_VROW + R * 2); const u32x4 vv = vq[it];
                          vp[0 * (AT_VROW / 2)] = (unsigned short)(vv.x & 0xffffu); vp[1 * (AT_VROW / 2)] = (unsigned short)(vv.x >> 16);
                          vp[2 * (AT_VROW / 2)] = (unsigned short)(vv.y & 0xffffu); vp[3 * (AT_VROW / 2)] = (unsigned short)(vv.y >> 16);
                          vp[4 * (AT_VROW / 2)] = (unsigned short)(vv.z & 0xffffu); vp[5 * (AT_VROW / 2)] = (unsigned short)(vv.z >> 16);
                          vp[6 * (AT_VROW / 2)] = (unsigned short)(vv.w & 0xffffu); vp[7 * (AT_VROW / 2)] = (unsigned short)(vv.w >> 16); }
                    }
                }
                for (int i = tid; i < 64 * 24; i += NWAVES * 64) *(LAS unsigned short*)(L + AT_V + (i / 24) * AT_VROW + (384 + i % 24) * 2) = (unsigned short)0;
                __syncthreads();
                if (w >= 4) __builtin_amdgcn_s_sleep(ATT_STAGGER);
                auto head_pairs = [&](auto fast_tag) {
                constexpr bool FAST = decltype(fast_tag)::value;
#pragma unroll 1
                for (int hp = 0; hp < 2; ++hp) {
                    const int hA = 4 * g + 2 * hp;
                    bf16x8_t qA[2], qB[2];
#pragma unroll
                    for (int s2 = 0; s2 < 2; ++s2) { qA[s2] = *(const bf16x8_t*)(Q + qrow * 512 + 64 * hA + 32 * s2 + 8 * h4); qB[s2] = *(const bf16x8_t*)(Q + qrow * 512 + 64 * hA + 64 + 32 * s2 + 8 * h4); }
                    f32x4 sA[17], sB[17];
#pragma unroll
                    for (int kb = 0; kb < 17; ++kb) {
                        const LAS unsigned char* kp = L + AT_K + (16 * (w + kb) + l15) * AT_KROW;
                        const bf16x8_t k0 = *(const LAS bf16x8_t*)(kp + ((h4 ^ (l15 & 7)) * 16)), k1 = *(const LAS bf16x8_t*)(kp + (((4 + h4) ^ (l15 & 7)) * 16));
                        f32x4 a = FAST ? negB : (f32x4){0.f, 0.f, 0.f, 0.f}, b = a;
                        a = mfma16(k0, qA[0], a); b = mfma16(k0, qB[0], b); a = mfma16(k1, qA[1], a); b = mfma16(k1, qB[1], b);
                        sA[kb] = a; sB[kb] = b;
                    }
                    __builtin_amdgcn_sched_barrier(0);
                    const float NEG = -1e30f;
                    if (edge) {
#pragma unroll
                        for (int kb = 0; kb < 17; ++kb) if (kb < kb_lo || kb >= kb_hi) { sA[kb] = (f32x4){NEG, NEG, NEG, NEG}; sB[kb] = (f32x4){NEG, NEG, NEG, NEG}; }
                    }
#pragma unroll
                    for (int i = 0; i < 4; ++i) { if (4 * h4 + i < l15) { sA[0][i] = NEG; sB[0][i] = NEG; } if (4 * h4 + i > l15) { sA[16][i] = NEG; sB[16][i] = NEG; } }
                    const float skA = sink[hA] * LOG2E, skB = sink[hA + 1] * LOG2E;
                    float mxA = 0.f, mxB = 0.f;
                    if (!FAST) {
                        mxA = skA; mxB = skB;
#pragma unroll
                        for (int kb = 0; kb < 17; ++kb) { mxA = fmaxf(fmaxf(mxA, fmaxf(sA[kb].x, sA[kb].y)), fmaxf(sA[kb].z, sA[kb].w)); mxB = fmaxf(fmaxf(mxB, fmaxf(sB[kb].x, sB[kb].y)), fmaxf(sB[kb].z, sB[kb].w)); }
                        mxA = xmax_16_32(mxA); mxB = xmax_16_32(mxB);
                    }
                    __builtin_amdgcn_sched_barrier(0);
                    u32x2 pA[18], pB[18];
#pragma unroll
                    for (int kb = 0; kb < 17; ++kb) {
                        f32x4 p; if (FAST) { p.x = __builtin_amdgcn_exp2f(sA[kb].x); p.y = __builtin_amdgcn_exp2f(sA[kb].y); p.z = __builtin_amdgcn_exp2f(sA[kb].z); p.w = __builtin_amdgcn_exp2f(sA[kb].w); } else { p.x = __builtin_amdgcn_exp2f(sA[kb].x - mxA); p.y = __builtin_amdgcn_exp2f(sA[kb].y - mxA); p.z = __builtin_amdgcn_exp2f(sA[kb].z - mxA); p.w = __builtin_amdgcn_exp2f(sA[kb].w - mxA); }
                        pA[kb] = cvtpk2(p);
                        f32x4 q; if (FAST) { q.x = __builtin_amdgcn_exp2f(sB[kb].x); q.y = __builtin_amdgcn_exp2f(sB[kb].y); q.z = __builtin_amdgcn_exp2f(sB[kb].z); q.w = __builtin_amdgcn_exp2f(sB[kb].w); } else { q.x = __builtin_amdgcn_exp2f(sB[kb].x - mxB); q.y = __builtin_amdgcn_exp2f(sB[kb].y - mxB); q.z = __builtin_amdgcn_exp2f(sB[kb].z - mxB); q.w = __builtin_amdgcn_exp2f(sB[kb].w - mxB); }
                        pB[kb] = cvtpk2(q);
                    }
                    pA[17] = (u32x2){0u, 0u}; pB[17] = (u32x2){0u, 0u};
                    __builtin_amdgcn_sched_barrier(0);
                    f32x4 lsA = (f32x4){0.f, 0.f, 0.f, 0.f}, lsB = (f32x4){0.f, 0.f, 0.f, 0.f};
                    f32x4 oA[4], oB[4];
#pragma unroll
                    for (int db = 0; db < 4; ++db) { oA[db] = (f32x4){0.f, 0.f, 0.f, 0.f}; oB[db] = (f32x4){0.f, 0.f, 0.f, 0.f}; }
#pragma unroll
                    for (int s2 = 0; s2 < 9; ++s2) {
                        u32x4 pa, pb; pa.x = pA[2 * s2].x; pa.y = pA[2 * s2].y; pa.z = pA[2 * s2 + 1].x; pa.w = pA[2 * s2 + 1].y; pb.x = pB[2 * s2].x; pb.y = pB[2 * s2].y; pb.z = pB[2 * s2 + 1].x; pb.w = pB[2 * s2 + 1].y;
                        const bf16x8_t pfA = __builtin_bit_cast(bf16x8_t, pa), pfB = __builtin_bit_cast(bf16x8_t, pb);
                        lsA = mfma16(ones8, pfA, lsA); lsB = mfma16(ones8, pfB, lsB);
#pragma unroll
                        for (int db = 0; db < 4; ++db) {
                            const LAS unsigned char* vp = L + AT_V + (16 * db + l15) * AT_VROW + (16 * w + 32 * s2 + 4 * h4) * 2;
                            const u32x2 lo = *(const LAS u32x2*)vp, hi = *(const LAS u32x2*)(vp + 32);
                            u32x4 vw; vw.x = lo.x; vw.y = lo.y; vw.z = hi.x; vw.w = hi.y;
                            const bf16x8_t vf = __builtin_bit_cast(bf16x8_t, vw);
                            oA[db] = mfma16(vf, pfA, oA[db]); oB[db] = mfma16(vf, pfB, oB[db]);
                        }
                    }
                    const float invA = __builtin_amdgcn_rcpf(lsA.x + __builtin_amdgcn_exp2f(skA - (FAST ? bref : mxA))), invB = __builtin_amdgcn_rcpf(lsB.x + __builtin_amdgcn_exp2f(skB - (FAST ? bref : mxB)));
                    {
                        LAS unsigned char* so = L + AT_O + w * (16 * AT_OROW);
#pragma unroll
                        for (int db = 0; db < 4; ++db) {
                            const f32x4 va = oA[db] * invA, vb = oB[db] * invB;
                            ssq += ((va.x * va.x + va.y * va.y) + (va.z * va.z + va.w * va.w)) + ((vb.x * vb.x + vb.y * vb.y) + (vb.z * vb.z + vb.w * vb.w));
                            u32x2 pk; pk.x = cvtpk(va.x, va.y); pk.y = cvtpk(va.z, va.w); *(LAS u32x2*)(so + l15 * AT_OROW + (16 * db + 4 * h4) * 2) = pk;
                            u32x2 pl; pl.x = cvtpk(vb.x, vb.y); pl.y = cvtpk(vb.z, vb.w); *(LAS u32x2*)(so + l15 * AT_OROW + (64 + 16 * db + 4 * h4) * 2) = pl;
                        }
                        asm volatile("s_waitcnt lgkmcnt(0)" ::: "memory");
#pragma unroll
                        for (int i = 0; i < 4; ++i) { const int row = 4 * i + h4; const u32x4 v = *(const LAS u32x4*)(so + row * AT_OROW + l15 * 16);
                            *(u32x4*)(MG + (size_t)(m0 + 16 * w + row) * D_MODEL + 64 * hA + 8 * l15) = v; }
                        asm volatile("s_waitcnt lgkmcnt(0)" ::: "memory");
                    }
                }
                };
                if (fast_ref) head_pairs(std::true_type{}); else head_pairs(std::false_type{});
                __syncthreads();
            }
            ssq = xsum_16_32(ssq);
            const int tl = lane_id(), tl15 = tl & 15;
            if ((tl >> 4) == 0) { const float ms = ssq * (1.0f / 512.0f) + EPS;
                *(LAS float*)(L + MX_RA + (16 * w + tl15) * 4) = ms * rsq_(ms);
                ((float*)(C.ws + WS_ARSTD))[m0 + 16 * w + tl15] = rsq_(ms); }
        }
        __syncthreads();
        {
            MIX_LANES();
            const bf16* GL = (const bf16*)(C.ws + WS_GLU);
            const float* cw = C.fin(I_CONV_W, (size_t)l * CONV_W * CONV_CH); const float* cb = C.fin(I_CONV_B, l * CONV_CH);
            const float* lg = C.fin(I_CONV_LN_G, l * CONV_CH); const float* lb = C.fin(I_CONV_LN_B, l * CONV_CH);
            const int c = tid & 255, q2 = tid >> 8;
            for (int i = tid; i < CONV_W * CONV_CH / 4; i += NWAVES * 64) *(LAS f32x4*)(L + CV_W + i * 16) = *((const f32x4*)cw + i);
            const float cbias = cb[c];
            f32x4 cg4[4], cb4[4];
#pragma unroll
            for (int k = 0; k < 4; ++k) { cg4[k] = *(const f32x4*)(lg + 4 * (lane & 15) + 64 * k); cb4[k] = *(const f32x4*)(lb + 4 * (lane & 15) + 64 * k); }
#pragma unroll 1
            for (int hp = 0; hp < 2; ++hp) {
                {
                    u32x4 sv[6];
#pragma unroll
                    for (int it = 0; it < 6; ++it) {
                        const int i = tid + it * (NWAVES * 64), ic = i < 94 * 32 ? i : 94 * 32 - 1, R = ic >> 5, ch = ic & 31, tp = tpos0 + 64 * hp - CONV_PAD + R;
                        const int tpc = tp < 0 ? 0 : (tp > SEQ - 1 ? SEQ - 1 : tp);
                        sv[it] = *(const u32x4*)(GL + (size_t)(m0 - tpos0 + tpc) * 256 + ch * 8);
                        if (tp != tpc) sv[it] = (u32x4){0u, 0u, 0u, 0u};
                    }
#pragma unroll
                    for (int it = 0; it < 6; ++it) { const int i = tid + it * (NWAVES * 64); if (i < 94 * 32) *(LAS u32x4*)(L + CV_G + (i >> 5) * CV_GROW + (i & 31) * 16) = sv[it]; }
                }
                __syncthreads();
                typedef float f32x2p __attribute__((ext_vector_type(2)));
                f32x2p w2[CONV_W + 1];
                {
                    float wk[CONV_W];
#pragma unroll
                    for (int k = 0; k < CONV_W; ++k) wk[k] = *(const LAS float*)(L + CV_W + k * (CONV_CH * 4) + c * 4);
#pragma unroll
                    for (int k = 0; k <= CONV_W; ++k) { w2[k].x = (k < CONV_W) ? wk[k] : 0.f; w2[k].y = (k > 0) ? wk[k - 1] : 0.f; }
                }
#pragma unroll 1
                for (int ob = 0; ob < 4; ++ob) {
                    f32x2p acc2[4];
#pragma unroll
                    for (int p2 = 0; p2 < 4; ++p2) acc2[p2] = (f32x2p){cbias, cbias};
                    const LAS unsigned short* gp = (const LAS unsigned short*)(L + CV_G + (32 * q2 + 8 * ob) * CV_GROW + c * 2);
                    unsigned short gx[38];
#pragma unroll
                    for (int j = 0; j < 38; ++j) gx[j] = gp[j * (CV_GROW / 2)];
                    __builtin_amdgcn_sched_barrier(0);
#pragma unroll
                    for (int j = 0; j < 38; ++j) {
                        const float x = __builtin_bit_cast(float, (unsigned)gx[j] << 16); const f32x2p x2 = (f32x2p){x, x};
#pragma unroll
                        for (int p2 = 0; p2 < 4; ++p2) { const int k = j - 2 * p2; if (k >= 0 && k <= CONV_W) acc2[p2] = __builtin_elementwise_fma(w2[k], x2, acc2[p2]); }
                    }
#pragma unroll
                    for (int p2 = 0; p2 < 4; ++p2) { *(LAS float*)(L + CV_Y + (32 * q2 + 8 * ob + 2 * p2) * CV_YROW + c * 4) = acc2[p2].x; *(LAS float*)(L + CV_Y + (32 * q2 + 8 * ob + 2 * p2 + 1) * CV_YROW + c * 4) = acc2[p2].y; }
                }
                __syncthreads();
                {
                    const int s16 = lane & 15, rsub = lane >> 4;
                    f32x4 v[2][4]; float t[2];
#pragma unroll
                    for (int bb = 0; bb < 2; ++bb)
#pragma unroll
                        for (int k = 0; k < 4; ++k) v[bb][k] = *(const LAS f32x4*)(L + CV_Y + (8 * w + 4 * bb + rsub) * CV_YROW + s16 * 16 + 256 * k);
#pragma unroll
                    for (int bb = 0; bb < 2; ++bb) { f32x4 a = (v[bb][0] + v[bb][1]) + (v[bb][2] + v[bb][3]); t[bb] = (a.x + a.y) + (a.z + a.w); }
#pragma unroll
                    for (int bb = 0; bb < 2; ++bb) t[bb] = rowsum16(t[bb]) * (1.0f / 256.0f);
#pragma unroll
                    for (int bb = 0; bb < 2; ++bb) { f32x4 q = (f32x4){0.f, 0.f, 0.f, 0.f};
#pragma unroll
                        for (int k = 0; k < 4; ++k) { v[bb][k] = v[bb][k] - t[bb]; q += v[bb][k] * v[bb][k]; }
                        t[bb] = (q.x + q.y) + (q.z + q.w); }
#pragma unroll
                    for (int bb = 0; bb < 2; ++bb) t[bb] = rsq_(rowsum16(t[bb]) * (1.0f / 256.0f) + EPS);
#pragma unroll
                    for (int bb = 0; bb < 2; ++bb) { f32x4 q = (f32x4){0.f, 0.f, 0.f, 0.f};
#pragma unroll
                        for (int k = 0; k < 4; ++k) { f32x4 y = v[bb][k] * t[bb] * cg4[k] + cb4[k];
                            y.x *= __builtin_amdgcn_rcpf(1.0f + __builtin_amdgcn_exp2f(-LOG2E * y.x)); y.y *= __builtin_amdgcn_rcpf(1.0f + __builtin_amdgcn_exp2f(-LOG2E * y.y));
                            y.z *= __builtin_amdgcn_rcpf(1.0f + __builtin_amdgcn_exp2f(-LOG2E * y.z)); y.w *= __builtin_amdgcn_rcpf(1.0f + __builtin_amdgcn_exp2f(-LOG2E * y.w));
                            v[bb][k] = y; q += y * y; }
                        t[bb] = (q.x + q.y) + (q.z + q.w); }
#pragma unroll
                    for (int bb = 0; bb < 2; ++bb) t[bb] = rsq_(rowsum16(t[bb]) * (1.0f / 256.0f) + EPS);
#pragma unroll
                    for (int bb = 0; bb < 2; ++bb)
#pragma unroll
                        for (int k = 0; k < 4; ++k) { const f32x4 y = v[bb][k] * (t[bb] * *(const LAS float*)(L + MX_RA + (64 * hp + 8 * w + 4 * bb + rsub) * 4)); u32x2 o; o.x = cvtpk(y.x, y.y); o.y = cvtpk(y.z, y.w);
                            *(u32x2*)(MG + (size_t)(m0 + 64 * hp + 8 * w + 4 * bb + rsub) * D_MODEL + 768 + 4 * s16 + 64 * k) = o; }
                }
                __syncthreads();
            }
        }
        {
            MIX_LANES();
            const bf16* VV = (const bf16*)(C.ws + WS_VV); const bf16* U = (const bf16*)(C.ws + WS_U);
            const float* lg = C.fin(I_GM_LN_G, l * GM_WIDTH); const float* lb = C.fin(I_GM_LN_B, l * GM_WIDTH);
            const bf16* Wb = (const bf16*)(C.ws + WS_WSBF) + (size_t)l * GM_HEADS * CHUNK * CHUNK; const float* bsp = C.fin(I_GM_BS, l * GM_HEADS * CHUNK);
            const int p = 16 * w + l15;
            bf16x8_t bw[4][4]; u32x2 uq[16]; float bsv[4];
#pragma unroll
            for (int h = 0; h < 4; ++h) {
#pragma unroll
                for (int s2 = 0; s2 < 4; ++s2) bw[h][s2] = *(const bf16x8_t*)(Wb + ((size_t)(h * CHUNK + p)) * CHUNK + 32 * s2 + 8 * h4);
                bsv[h] = bsp[h * CHUNK + p];
            }
            {
                const int s16 = lane & 15, rsub = lane >> 4;
                u32x4 xv[4][2]; float t[4], mu[4];
#pragma unroll
                for (int bb = 0; bb < 4; ++bb)
#pragma unroll
                    for (int k = 0; k < 2; ++k) xv[bb][k] = *(const u32x4*)(VV + (size_t)(m0 + 16 * w + 4 * bb + rsub) * 256 + 16 * s16 + 8 * k);
#pragma unroll
                for (int bb = 0; bb < 4; ++bb) { float a = 0.f;
#pragma unroll
                    for (int k = 0; k < 2; ++k) a += ((bflo(xv[bb][k].x) + bfhi(xv[bb][k].x)) + (bflo(xv[bb][k].y) + bfhi(xv[bb][k].y))) + ((bflo(xv[bb][k].z) + bfhi(xv[bb][k].z)) + (bflo(xv[bb][k].w) + bfhi(xv[bb][k].w)));
                    t[bb] = a; }
#pragma unroll
                for (int bb = 0; bb < 4; ++bb) mu[bb] = rowsum16(t[bb]) * (1.0f / 256.0f);
#pragma unroll
                for (int bb = 0; bb < 4; ++bb) { float a = 0.f; const float m_ = mu[bb];
#pragma unroll
                    for (int k = 0; k < 2; ++k) { const u32x4 x = xv[bb][k];
                        const float d0 = bflo(x.x) - m_, d1 = bfhi(x.x) - m_, d2 = bflo(x.y) - m_, d3 = bfhi(x.y) - m_, d4 = bflo(x.z) - m_, d5 = bfhi(x.z) - m_, d6 = bflo(x.w) - m_, d7 = bfhi(x.w) - m_;
                        a += ((d0 * d0 + d1 * d1) + (d2 * d2 + d3 * d3)) + ((d4 * d4 + d5 * d5) + (d6 * d6 + d7 * d7)); }
                    t[bb] = a; }
#pragma unroll
                for (int bb = 0; bb < 4; ++bb) { const float var = rowsum16(t[bb]) * (1.0f / 256.0f);
                    if (s16 == 0) { const int q = 16 * w + 4 * bb + rsub; *(LAS float*)(L + GM_ST + q * 8) = mu[bb]; *(LAS float*)(L + GM_ST + q * 8 + 4) = rsq_(var + EPS); } }
            }
            __syncthreads();
            {
                const int q = tid & 127, dblk = tid >> 7;
                const float mean = *(const LAS float*)(L + GM_ST + q * 8), rstd = *(const LAS float*)(L + GM_ST + q * 8 + 4);
#pragma unroll
                for (int j = 0; j < 8; ++j) {
                    const int d0 = dblk * 64 + 8 * j;
                    const u32x4 x = *(const u32x4*)(VV + (size_t)(m0 + q) * 256 + d0);
                    const f32x4 ga = *(const f32x4*)(lg + d0), gb = *(const f32x4*)(lg + d0 + 4), ba = *(const f32x4*)(lb + d0), bb = *(const f32x4*)(lb + d0 + 4);
                    const float v[8] = {bflo(x.x), bfhi(x.x), bflo(x.y), bfhi(x.y), bflo(x.z), bfhi(x.z), bflo(x.w), bfhi(x.w)};
                    const float gg[8] = {ga.x, ga.y, ga.z, ga.w, gb.x, gb.y, gb.z, gb.w}, bbv[8] = {ba.x, ba.y, ba.z, ba.w, bb.x, bb.y, bb.z, bb.w};
#pragma unroll
                    for (int e = 0; e < 8; ++e) *(LAS unsigned short*)(L + GM_T + (d0 + e) * GM_TROW + q * 2) = (unsigned short)f2bf((v[e] - mean) * rstd * gg[e] + bbv[e]);
                }
            }
            __syncthreads();
            {
#pragma unroll
                for (int db = 0; db < 16; ++db) uq[db] = *(const u32x2*)(U + (size_t)(m0 + p) * 256 + 16 * db + 4 * h4);
                f32x4 acc[16];
                bf16x8_t af[2][2][4];
#define GM_RD(hb_) do { _Pragma("unroll") for (int dbl = 0; dbl < 2; ++dbl) _Pragma("unroll") for (int s2 = 0; s2 < 4; ++s2) \
        af[(hb_) & 1][dbl][s2] = *(const LAS bf16x8_t*)(L + GM_T + (16 * (2 * (hb_) + dbl) + l15) * GM_TROW + 64 * s2 + 16 * h4); } while (0)
                GM_RD(0);
#pragma unroll
                for (int hb = 0; hb < 8; ++hb) {
                    __builtin_amdgcn_sched_barrier(0);
                    if (hb + 1 < 8) GM_RD(hb + 1);
                    __builtin_amdgcn_sched_barrier(0);
                    f32x4 a0 = (f32x4){0.f, 0.f, 0.f, 0.f}, a1 = (f32x4){0.f, 0.f, 0.f, 0.f};
#pragma unroll
                    for (int s2 = 0; s2 < 4; ++s2) { a0 = mfma16(af[hb & 1][0][s2], bw[hb >> 1][s2], a0); a1 = mfma16(af[hb & 1][1][s2], bw[hb >> 1][s2], a1); }
                    acc[2 * hb] = a0; acc[2 * hb + 1] = a1;
                }
                __builtin_amdgcn_sched_barrier(0);
#undef GM_RD
                float ss = 0.f;
#pragma unroll
                for (int db = 0; db < 16; ++db) {
                    const float bias = bsv[db >> 2];
                    const u32x2 uu = uq[db];
                    f32x4 o; o.x = bflo(uu.x) * (acc[db].x + bias); o.y = bfhi(uu.x) * (acc[db].y + bias); o.z = bflo(uu.y) * (acc[db].z + bias); o.w = bfhi(uu.y) * (acc[db].w + bias);
                    acc[db] = o; ss += (o.x * o.x + o.y * o.y) + (o.z * o.z + o.w * o.w);
                }
                ss = xsum_16_32(ss);
                const float r = rsq_(ss * (1.0f / 256.0f) + EPS) * *(const LAS float*)(L + MX_RA + p * 4);
#pragma unroll
                for (int db = 0; db < 16; ++db) { u32x2 o; o.x = cvtpk(acc[db].x * r, acc[db].y * r); o.y = cvtpk(acc[db].z * r, acc[db].w * r);
                    *(u32x2*)(MG + (size_t)(m0 + p) * D_MODEL + 512 + 16 * db + 4 * h4) = o; }
            }
            __syncthreads();
        }
        __syncthreads();
    }
}

constexpr int STEPS_PER_LAYER = 6, N_STEPS = 1 + DEPTH * STEPS_PER_LAYER;

template <int S>
__device__ __forceinline__ void run_step(const Ctx& C) {
    float* partA = (float*)(C.ws + WS_PARTA); float* partB = (float*)(C.ws + WS_PARTB);
    if constexpr (S == 0) { step_prologue(C); step_wprep(C); }
    else {
        constexpr int l = (S - 1) / STEPS_PER_LAYER, k = (S - 1) % STEPS_PER_LAYER;
        float* pin = (l & 1) ? partB : partA; float* pot = (l & 1) ? partA : partB;
        bf16* XB = (bf16*)(C.ws + WS_XBF); bf16* XB2 = (bf16*)(C.ws + WS_XBF2);
        if constexpr (k == 0) { for (int rip_ = 0; rip_ < REP_IP; ++rip_) { step_inproj_opt(C, l, pin); if (rip_ + 1 < REP_IP) __syncthreads(); } }
        else if constexpr (k == 1) step_mixer_opt(C, l);
        else if constexpr (k == 2) step_resid_opt<0, false, true>(C, (const bf16*)(C.ws + WS_MERGED), D_MODEL, wcopy(C, l, WO_OUT), l == 0 ? XB : XB2, XB, nullptr, pot);
        else if constexpr (k == 3) { for (int rgu_ = 0; rgu_ < REP_GU; ++rgu_) { step_gateup_opt(C, l, pot); if (rgu_ + 1 < REP_GU) __syncthreads(); } }
        else if constexpr (k == 4) step_resid_opt<0, false, false, true>(C, (const bf16*)(C.ws + WS_ACT), ACT_ROW_BYTES / 2, wcopy(C, l, WO_DOWN), XB, XB, nullptr, pin);
        else { const bf16* X8A = (const bf16*)(C.ws + WS_X8);
               if constexpr (l == DEPTH - 1) step_resid_opt<1, true, false, true>(C, X8A, D_MODEL / 2, wcopy(C, l, WO_PG), XB, XB2, pin, pot);
               else step_resid_opt<1, false, false, true>(C, X8A, D_MODEL / 2, wcopy(C, l, WO_PG), XB, XB2, pin, pot); }
    }
}
__device__ __forceinline__ Ctx make_ctx(const Args& args, int wave, LAS unsigned char* lds) {
    Ctx C; C.a = &args; C.ws = args.ws; C.out = args.out; C.lds = lds;
    C.lane = lane_id(); C.wave = wave; C.tid = wave * 64 + C.lane;
    C.gw = blockIdx.x * NWAVES + wave; C.ngw = gridDim.x * NWAVES; C.gtid = blockIdx.x * (NWAVES * 64) + C.tid; C.ngt = gridDim.x * NWAVES * 64;
    return C;
}
template <int S>
__device__ __forceinline__ void run_steps(const Args& args, int wave, LAS unsigned char* lds, const XcdBarrier& bar, int lo, int hi) {
    if constexpr (S < N_STEPS) {
        if (lo <= S && S < hi) {
            if (S == REPEAT_STEP) { { const Ctx C = make_ctx(args, wave, lds); run_step<S>(C); } xcd_barrier(bar, wave == 0 && lane_id() == 0); }
            { constexpr int kq = (S >= 1) ? (S - 1) % STEPS_PER_LAYER : -1;
              if (kq == 3 && gridDim.x == 256 && hi - lo > 1) mixer_done_wait((unsigned*)(args.ws + WS_CTL), 256u * (unsigned)((S - 1) / STEPS_PER_LAYER + 1), wave == 0 && lane_id() == 0); }
            { const Ctx C = make_ctx(args, wave, lds); run_step<S>(C); }
            if (S + 1 < hi) { constexpr int kk = (S >= 1) ? (S - 1) % STEPS_PER_LAYER : -1;
                if (kk >= 0 && kk <= 4 && gridDim.x == 256) {
                    int nb = -1;
                    if (kk == 0) { const int c = (int)blockIdx.x, u = 2 * (16 * (c & 7) + ((c >> 3) & 7) + 8 * (c >> 7)) + ((c >> 6) & 1), pn_ = (u & 1) ? (u >> 1) + 1 : (u >> 1) - 1;
                        if (pn_ >= 0 && pn_ < M / 256) nb = (pn_ >> 4) * 8 + (pn_ & 7); }
                    quad_barrier((unsigned*)(args.ws + WS_CTL), (volatile LAS unsigned*)(lds + MISC_OFF) + 12, bar.x, (unsigned)(5 * ((S - 1) / STEPS_PER_LAYER) + kk), wave == 0 && lane_id() == 0, kk == 1, nb); }
                else xcd_barrier(bar, wave == 0 && lane_id() == 0); } }
        run_steps<S + 1>(args, wave, lds, bar, lo, hi);
    }
}

__global__ void __launch_bounds__(NWAVES * 64) __attribute__((amdgpu_waves_per_eu(2, 2))) mega(Args args) {
    extern __shared__ __attribute__((aligned(16))) unsigned char lds_raw[];
    LAS unsigned char* lds = (LAS unsigned char*)lds_raw;
    const int wave = __builtin_amdgcn_readfirstlane(threadIdx.x >> 6);
    volatile LAS unsigned* MISC = (volatile LAS unsigned*)(lds + MISC_OFF);
    for (int u = threadIdx.x; u < (LDS_BYTES - LDSCTL_OFF) / 4; u += NWAVES * 64) ((LAS unsigned*)(lds + LDSCTL_OFF))[u] = 0u;
    __syncthreads();
    unsigned* ctl = (unsigned*)(args.ws + WS_CTL);
    XcdBarrier bar; bar.bar = ctl + CW_BAR; bar.x = 0; bar.st = nullptr;
    const bool multi = (args.st_hi - args.st_lo) > 1;
    if (multi) { bar = xcd_barrier_post(ctl + CW_BAR + args.li * XCD_BAR_WORDS, MISC + 8, wave == 0 && lane_id() == 0);
        if (wave == 0 && lane_id() == 0) __hip_atomic_store(ctl + CW_XID + blockIdx.x, bar.x + 1u, __ATOMIC_RELAXED, __HIP_MEMORY_SCOPE_AGENT); }
    run_steps<0>(args, wave, lds, bar, args.st_lo, args.st_hi);
}

extern "C" void kernel_launch(void* const* d_in, const int* in_sizes, int n_in, void* d_out, int out_size, void* d_ws, size_t ws_size, hipStream_t stream) {
    static int grid = 0;
    if (grid == 0) {
        if (n_in != N_IN || in_sizes[0] != M * D_MODEL || out_size != M * D_MODEL || ws_size < WS_END) {
            fprintf(stderr, "kernel_launch: shape/workspace mismatch (n_in %d, in0 %d, out %d, ws %zu, need %zu); nothing launched\n", n_in, n_in > 0 ? in_sizes[0] : -1, out_size, ws_size, (size_t)WS_END); grid = -1; return; }
        int dev = 0, cus = 0, per_cu = 0;
        if (hipGetDevice(&dev) != hipSuccess || hipDeviceGetAttribute(&cus, hipDeviceAttributeMultiprocessorCount, dev) != hipSuccess) { grid = -1; return; }
        if (hipFuncSetAttribute((const void*)mega, hipFuncAttributeMaxDynamicSharedMemorySize, LDS_BYTES) != hipSuccess) { fprintf(stderr, "kernel_launch: hipFuncSetAttribute failed\n"); grid = -1; return; }
        if (hipOccupancyMaxActiveBlocksPerMultiprocessor(&per_cu, (const void*)mega, NWAVES * 64, LDS_BYTES) != hipSuccess || per_cu < 1) { fprintf(stderr, "kernel_launch: occupancy query says %d blocks per CU; nothing launched\n", per_cu); (void)hipGetLastError(); grid = -1; return; }
        grid = cus;
    }
    if (grid < 0) return;
    if (hipMemsetAsync((char*)d_ws + WS_CTL, 0, CTL_ZERO_BYTES, stream) != hipSuccess) return;
    Args a{};
    for (int i = 0; i < N_IN; ++i) a.in[i] = d_in[i];
    a.out = (float*)d_out; a.ws = (unsigned char*)d_ws;
    if (MK_N_LAUNCHES == 1) {
        a.st_lo = 0; a.st_hi = N_STEPS; a.li = 0;
        hipLaunchKernelGGL(mega, dim3(grid), dim3(NWAVES * 64), LDS_BYTES, stream, a);
    } else {
        for (int s = 0; s < N_STEPS; ++s) { a.st_lo = s; a.st_hi = s + 1; a.li = 0; hipLaunchKernelGGL(mega, dim3(grid), dim3(NWAVES * 64), LDS_BYTES, stream, a); }
    }
}
```
